# Optimizing an MI355X kernel written in HIP

```python
import jax, jax.numpy as jnp
from jax import lax
import numpy as np

D_MODEL = 1024
BATCH = 2
SEQ = 16384
DEPTH = 2

CHUNK = 64
Q_BLOCK = 128
NORM_EPS = 1e-6
ROPE_THETA = 500000.0

A_HEADS = 8
A_KV_HEADS = 2
A_HEAD_DIM = 64
IDX_HEADS = 4
IDX_DIM = 64
TOPK_MAX = 256
ROT_DIM = A_HEAD_DIM // 4
B_HEADS = 8
B_HEAD_DIM = 64
B_LEFT_CHUNKS = 8
B_MAX_REL = 128
C_HEADS = 4
C_HEAD_DIM = 128
C_CONV = 4

A_WIDTH = A_HEADS * A_HEAD_DIM
A_KV_WIDTH = A_KV_HEADS * A_HEAD_DIM
B_WIDTH = B_HEADS * B_HEAD_DIM
C_WIDTH = C_HEADS * C_HEAD_DIM
BRANCH_WIDTH = 512
N_BRANCH = 3
IN_SPLITS = (A_WIDTH, A_KV_WIDTH, A_KV_WIDTH, IDX_HEADS * IDX_DIM, IDX_DIM, IDX_HEADS, A_WIDTH,
             B_WIDTH, B_WIDTH, B_WIDTH, B_WIDTH,
             C_WIDTH, C_WIDTH, C_WIDTH, C_HEADS, C_HEADS, C_WIDTH, C_WIDTH,
             N_BRANCH * D_MODEL)
IN_WIDTH = sum(IN_SPLITS)

kernel_name = 'hybrid_dsa_chunkattn_mlstm_block'


def rms_norm(x, g):
    xf = x.astype(jnp.float32)
    y = xf * lax.rsqrt(jnp.mean(xf * xf, axis=-1, keepdims=True) + NORM_EPS)
    return (y * g.astype(jnp.float32)).astype(x.dtype)


def rope_tables(S):
    half = ROT_DIM // 2
    inv_freq = 1.0 / (ROPE_THETA ** (jnp.arange(half, dtype=jnp.float32) * 2.0 / ROT_DIM))
    ang = jnp.arange(S, dtype=jnp.float32)[:, None] * inv_freq[None, :]
    return jnp.cos(ang), jnp.sin(ang)


def partial_rope(x, cos, sin):
    half = ROT_DIM // 2
    xf = x.astype(jnp.float32)
    x1 = xf[..., :half]
    x2 = xf[..., half:ROT_DIM]
    c = cos[:, None, :]
    s = sin[:, None, :]
    return jnp.concatenate([x1 * c - x2 * s, x2 * c + x1 * s, xf[..., ROT_DIM:]], axis=-1).astype(x.dtype)


def causal_depthwise_conv(x, w, b):
    K, C = w.shape
    y = lax.conv_general_dilated(x, w[:, None, :].astype(x.dtype), window_strides=(1,), padding=[(K - 1, 0)],
                                 dimension_numbers=('NWC', 'WIO', 'NWC'), feature_group_count=C)
    return y + b.astype(x.dtype)


def indexer_sparse_attention(q, k, v, iq, ik, iw):
    B, S = q.shape[0], q.shape[1]
    n_sel = min(TOPK_MAX, S // 4)
    nqb = S // Q_BLOCK
    G = A_HEADS // A_KV_HEADS
    scale = A_HEAD_DIM ** -0.5
    key_chunk = jnp.arange(S) // CHUNK
    iw = iw.astype(jnp.float32) * (IDX_DIM ** -0.5 * IDX_HEADS ** -0.5)

    def to_blocks(t):
        return jnp.swapaxes(t.reshape((B, nqb, Q_BLOCK) + t.shape[2:]), 0, 1)

    def one_block(args):
        qb, iqb, iwb, blk = args
        q_chunk = (blk * Q_BLOCK + jnp.arange(Q_BLOCK)) // CHUNK
        logits = jnp.einsum('bqhd,bsd->bqhs', iqb, ik, preferred_element_type=jnp.float32)
        score = jnp.einsum('bqhs,bqh->bqs', jax.nn.relu(logits), iwb)
        admissible = key_chunk[None, :] <= q_chunk[:, None]
        score = jnp.where(admissible[None], score, -jnp.inf)
        _, sel = lax.top_k(score, n_sel)
        sel_valid = key_chunk[sel] <= q_chunk[None, :, None]
        k_sel = jax.vmap(lambda kb, ib: kb[ib])(k, sel)
        v_sel = jax.vmap(lambda vb, ib: vb[ib])(v, sel)
        qg = qb.reshape(B, Q_BLOCK, A_KV_HEADS, G, A_HEAD_DIM)
        s = jnp.einsum('bqhgd,bqnhd->bhgqn', qg, k_sel, preferred_element_type=jnp.float32) * scale
        s = jnp.where(sel_valid[:, None, None], s, -jnp.inf)
        p = jax.nn.softmax(s, axis=-1).astype(v.dtype)
        o = jnp.einsum('bhgqn,bqnhd->bqhgd', p, v_sel)
        return o.reshape(B, Q_BLOCK, A_WIDTH)

    out = lax.map(one_block, (to_blocks(q), to_blocks(iq), to_blocks(iw), jnp.arange(nqb)))
    return jnp.swapaxes(out, 0, 1).reshape(B, S, A_WIDTH)


def chunked_relpos_attention(q, k, v, rel_bias):
    B, S = q.shape[0], q.shape[1]
    nc = S // CHUNK
    pad = B_LEFT_CHUNKS * CHUNK
    band = pad + CHUNK
    scale = B_HEAD_DIM ** -0.5
    kp = jnp.pad(k, ((0, 0), (pad, 0), (0, 0), (0, 0)))
    vp = jnp.pad(v, ((0, 0), (pad, 0), (0, 0), (0, 0)))
    rel = (pad + jnp.arange(CHUNK))[:, None] - jnp.arange(band)[None, :]
    bias = rel_bias.astype(jnp.float32)[:, jnp.clip(rel, -B_MAX_REL, B_MAX_REL) + B_MAX_REL]
    qc = jnp.swapaxes(q.reshape(B, nc, CHUNK, B_HEADS, B_HEAD_DIM), 0, 1)

    def one_chunk(args):
        qb, c = args
        start = c * CHUNK
        kb = lax.dynamic_slice_in_dim(kp, start, band, axis=1)
        vb = lax.dynamic_slice_in_dim(vp, start, band, axis=1)
        key_pos = start - pad + jnp.arange(band)
        s = jnp.einsum('bqhd,bkhd->bhqk', qb, kb, preferred_element_type=jnp.float32) * scale + bias[None]
        s = jnp.where((key_pos >= 0)[None, None, None, :], s, -jnp.inf)
        p = jax.nn.softmax(s, axis=-1).astype(v.dtype)
        o = jnp.einsum('bhqk,bkhd->bqhd', p, vb)
        return o.reshape(B, CHUNK, B_WIDTH)

    out = lax.map(one_chunk, (qc, jnp.arange(nc)))
    return jnp.swapaxes(out, 0, 1).reshape(B, S, B_WIDTH)


def mlstm_chunkwise(q, k, v, i_pre, f_pre, o_pre):
    B, S = q.shape[0], q.shape[1]
    nc = S // CHUNK
    H, d = C_HEADS, C_HEAD_DIM

    def chunks(t):
        t = t.astype(jnp.float32).reshape((B, nc, CHUNK) + t.shape[2:])
        return jnp.moveaxis(t, 3, 1)

    qc = chunks(q) * (d ** -0.5)
    kc = chunks(k)
    vc = chunks(v)
    ig = chunks(i_pre)
    log_f = jax.nn.log_sigmoid(chunks(f_pre))
    b = jnp.cumsum(log_f, axis=-1)
    g = b[..., -1]
    w_log = g[..., None] - b + ig
    m_loc = jnp.max(w_log, axis=-1)
    w = jnp.exp(w_log - m_loc[..., None])
    kv = jnp.einsum('bhcl,bhcld,bhcle->bhcde', w, kc, vc)
    ksum = jnp.einsum('bhcl,bhcld->bhcd', w, kc)

    def step(carry, xs):
        C, n, m = carry
        kv_c, ks_c, g_c, ml_c = xs
        m_new = jnp.maximum(g_c + m, ml_c)
        a = jnp.exp(g_c + m - m_new)
        bb = jnp.exp(ml_c - m_new)
        C_new = a[..., None, None] * C + bb[..., None, None] * kv_c
        n_new = a[..., None] * n + bb[..., None] * ks_c
        return (C_new, n_new, m_new), (C, n, m)

    init = (jnp.zeros((B, H, d, d), jnp.float32), jnp.zeros((B, H, d), jnp.float32), jnp.zeros((B, H), jnp.float32))
    xs = (jnp.moveaxis(kv, 2, 0), jnp.moveaxis(ksum, 2, 0), jnp.moveaxis(g, 2, 0), jnp.moveaxis(m_loc, 2, 0))
    _, (C_prev, n_prev, m_prev) = lax.scan(step, init, xs)
    C_prev = jnp.moveaxis(C_prev, 0, 2)
    n_prev = jnp.moveaxis(n_prev, 0, 2)
    m_prev = jnp.moveaxis(m_prev, 0, 2)

    causal = jnp.tril(jnp.ones((CHUNK, CHUNK), dtype=bool))
    D = jnp.where(causal, b[..., :, None] - b[..., None, :] + ig[..., None, :], -jnp.inf)
    m_inter = b + m_prev[..., None]
    m_row = jnp.maximum(m_inter, jnp.max(D, axis=-1))
    inter_scale = jnp.exp(m_inter - m_row)
    s_qk = jnp.einsum('bhcld,bhcsd->bhcls', qc, kc) * jnp.exp(D - m_row[..., None])
    num = jnp.einsum('bhcls,bhcse->bhcle', s_qk, vc) + inter_scale[..., None] * jnp.einsum('bhcld,bhcde->bhcle', qc, C_prev)
    den = jnp.sum(s_qk, axis=-1) + inter_scale * jnp.einsum('bhcld,bhcd->bhcl', qc, n_prev)
    h = num / jnp.maximum(jnp.abs(den), jnp.exp(-m_row))[..., None]
    h = jnp.moveaxis(h, 1, 3).reshape(B, S, H, d)
    return jax.nn.sigmoid(o_pre.astype(jnp.float32)) * h


def head_layer_norm(h, w):
    mu = jnp.mean(h, axis=-1, keepdims=True)
    hc = h - mu
    y = hc * lax.rsqrt(jnp.mean(hc * hc, axis=-1, keepdims=True) + NORM_EPS)
    return y.reshape(h.shape[0], h.shape[1], -1) * w.astype(jnp.float32)


def hybrid_layer(x, cos, sin, norm_g, w_in, b_in, f_bias, conv_w, conv_b, rel_bias, c_norm_w, w_branch, w_out):
    B, S, _ = x.shape
    h = rms_norm(x, norm_g)
    proj = jnp.einsum('bsd,de->bse', h, w_in) + b_in
    offsets = np.cumsum(IN_SPLITS)[:-1].tolist()
    (a_q, a_k, a_v, i_q, i_k, i_w, a_z, b_q, b_k, b_v, b_z,
     c_q, c_k, c_v, c_i, c_f, c_o, c_z, gates) = jnp.split(proj, offsets, axis=-1)
    a_q = partial_rope(a_q.reshape(B, S, A_HEADS, A_HEAD_DIM), cos, sin)
    a_k = partial_rope(a_k.reshape(B, S, A_KV_HEADS, A_HEAD_DIM), cos, sin)
    a_v = a_v.reshape(B, S, A_KV_HEADS, A_HEAD_DIM)
    i_q = partial_rope(i_q.reshape(B, S, IDX_HEADS, IDX_DIM), cos, sin)
    i_k = partial_rope(i_k.reshape(B, S, 1, IDX_DIM), cos, sin)[:, :, 0]
    y_a = indexer_sparse_attention(a_q, a_k, a_v, i_q, i_k, i_w)
    y_b = chunked_relpos_attention(b_q.reshape(B, S, B_HEADS, B_HEAD_DIM), b_k.reshape(B, S, B_HEADS, B_HEAD_DIM),
                                   b_v.reshape(B, S, B_HEADS, B_HEAD_DIM), rel_bias)
    qk = jax.nn.silu(causal_depthwise_conv(jnp.concatenate([c_q, c_k], axis=-1), conv_w, conv_b))
    c_q, c_k = jnp.split(qk, 2, axis=-1)
    y_c = mlstm_chunkwise(c_q.reshape(B, S, C_HEADS, C_HEAD_DIM), c_k.reshape(B, S, C_HEADS, C_HEAD_DIM),
                          c_v.reshape(B, S, C_HEADS, C_HEAD_DIM), c_i, c_f + f_bias,
                          c_o.reshape(B, S, C_HEADS, C_HEAD_DIM))
    y_c = head_layer_norm(y_c, c_norm_w).astype(x.dtype)
    branches = jnp.stack([y_a * jax.nn.silu(a_z), y_b * jax.nn.silu(b_z), y_c * jax.nn.silu(c_z)], axis=2)
    y = jnp.einsum('bsnw,nwd->bsnd', branches, w_branch)
    gate = jax.nn.sigmoid(gates.reshape(B, S, N_BRANCH, D_MODEL))
    merged = jnp.sum(gate * y, axis=2)
    return x + jnp.einsum('bsd,de->bse', merged, w_out)


def setup_inputs(seed: int = 0) -> dict:
    key = jax.random.key(seed)
    ks = jax.random.split(key, 13)
    f32 = jnp.float32
    x = jax.random.normal(ks[0], (BATCH, SEQ, D_MODEL), f32)
    norm_g = 1.0 + 0.01 * jax.random.normal(ks[1], (DEPTH, D_MODEL), f32)
    w_in = jax.random.normal(ks[2], (DEPTH, D_MODEL, IN_WIDTH), f32) * D_MODEL ** -0.5
    b_in = 0.01 * jax.random.normal(ks[3], (DEPTH, IN_WIDTH), f32)
    f_bias = jax.random.uniform(ks[4], (DEPTH, C_HEADS), f32, 3.0, 6.0)
    conv_w = jax.random.normal(ks[5], (DEPTH, C_CONV, 2 * C_WIDTH), f32) * C_CONV ** -0.5
    conv_b = 0.01 * jax.random.normal(ks[6], (DEPTH, 2 * C_WIDTH), f32)
    rel_bias = 0.1 * jax.random.normal(ks[7], (DEPTH, B_HEADS, 2 * B_MAX_REL + 1), f32)
    c_norm_w = 1.0 + 0.01 * jax.random.normal(ks[8], (DEPTH, C_WIDTH), f32)
    w_branch = jax.random.normal(ks[9], (DEPTH, N_BRANCH, BRANCH_WIDTH, D_MODEL), f32) * BRANCH_WIDTH ** -0.5
    w_out = jax.random.normal(ks[10], (DEPTH, D_MODEL, D_MODEL), f32) * D_MODEL ** -0.5
    final_g = 1.0 + 0.01 * jax.random.normal(ks[11], (D_MODEL,), f32)
    return {'x': x, 'norm_g': norm_g, 'w_in': w_in, 'b_in': b_in, 'f_bias': f_bias, 'conv_w': conv_w,
            'conv_b': conv_b, 'rel_bias': rel_bias, 'c_norm_w': c_norm_w, 'w_branch': w_branch,
            'w_out': w_out, 'final_g': final_g}


def reference(x, norm_g, w_in, b_in, f_bias, conv_w, conv_b, rel_bias, c_norm_w, w_branch, w_out, final_g):
    cos, sin = rope_tables(x.shape[1])
    for l in range(DEPTH):
        x = hybrid_layer(x, cos, sin, norm_g[l], w_in[l], b_in[l], f_bias[l], conv_w[l], conv_b[l],
                         rel_bias[l], c_norm_w[l], w_branch[l], w_out[l])
    return rms_norm(x, final_g)
```

```cpp
#include <hip/hip_runtime.h>
#include <hip/hip_cooperative_groups.h>
#include <cstdio>
namespace cg = cooperative_groups;
#ifndef DUP_G1
#define DUP_G1 1
#endif
#ifndef DUP_ASEL
#define DUP_ASEL 1
#endif
#ifndef DUP_AATT
#define DUP_AATT 1
#endif
#ifndef DUP_B
#define DUP_B 1
#endif
#ifndef DUP_C1
#define DUP_C1 1
#endif
#ifndef DUP_C3
#define DUP_C3 1
#endif
#ifndef DUP_G2
#define DUP_G2 1
#endif

typedef __bf16 bf8 __attribute__((ext_vector_type(8)));
typedef float f32x16 __attribute__((ext_vector_type(16)));
typedef float f32x4 __attribute__((ext_vector_type(4)));
typedef short s16x4 __attribute__((ext_vector_type(4)));
typedef unsigned short u16;
typedef unsigned int u32;
typedef unsigned long long u64;

constexpr int SEQ = 16384, NBATCH = 2, T_TOK = 32768, DM = 1024, NCH = 256;
constexpr int INW = 9292;
constexpr int C_AQ = 0, C_AK = 512, C_IQ = 768, C_IK = 1024, C_AZ = 1088, C_BQ = 1600, C_BK = 2112, C_BV = 2624, C_BZ = 3136,
              C_CQ = 3648, C_CK = 4160, C_CV = 4672, C_CO = 5184, C_CZ = 5696, C_SM = 6208, N1 = 6272, PLD = 6208;
constexpr int LDS_BYTES = 160 * 1024;

constexpr size_t al(size_t x) { return (x + 255) & ~(size_t)255; }
constexpr size_t OFF_CS = 0;
constexpr size_t OFF_WT1 = al(OFF_CS + (size_t)SEQ * 8 * 8);
constexpr size_t OFF_WG = al(OFF_WT1 + (size_t)2 * N1 * 1024 * 2);
constexpr size_t OFF_WB = al(OFF_WG + (size_t)2 * 3072 * 1024 * 2);
constexpr size_t OFF_WO = al(OFF_WB + (size_t)2 * 3 * 1024 * 512 * 2);
constexpr size_t OFF_B1 = al(OFF_WO + (size_t)2 * 1024 * 1024 * 2);
constexpr size_t OFF_BG = al(OFF_B1 + (size_t)2 * N1 * 4);
constexpr size_t OFF_XB = al(OFF_BG + (size_t)2 * 3072 * 4);
constexpr size_t OFF_R = al(OFF_XB + (size_t)T_TOK * 1024 * 2);
constexpr size_t OFF_P = al(OFF_R + (size_t)T_TOK * 4);
constexpr size_t OFF_KVA = al(OFF_P + (size_t)SEQ * PLD * 2);
constexpr size_t OFF_IK = al(OFF_KVA + (size_t)SEQ * 256 * 2);
constexpr size_t OFF_SM = al(OFF_IK + (size_t)SEQ * 64 * 2);
constexpr size_t OFF_YBR = al(OFF_SM + (size_t)SEQ * 16 * 4);
constexpr size_t OFF_KVS = al(OFF_YBR + (size_t)SEQ * 1536 * 2);
constexpr size_t OFF_NS = al(OFF_KVS + (size_t)4 * NCH * 128 * 128 * 4);
constexpr size_t OFF_GC = al(OFF_NS + (size_t)4 * NCH * 128 * 4);
constexpr size_t OFF_ML = al(OFF_GC + (size_t)4 * NCH * 4);
constexpr size_t OFF_MP = al(OFF_ML + (size_t)4 * NCH * 4);
constexpr size_t OFF_MG = al(OFF_MP + (size_t)4 * NCH * 4);
constexpr size_t WS_END = al(OFF_MG + (size_t)SEQ * 1024 * 2);
constexpr size_t OFF_CTL = WS_END;
constexpr size_t OFF_BAR = OFF_CTL + 1024;
constexpr size_t CTL_BYTES = 1024 + 3456 * 4;
constexpr size_t OFF_SEL = al(OFF_CTL + CTL_BYTES);
constexpr size_t OFF_CTB = al(OFF_SEL + (size_t)SEQ * 256 * 2);
constexpr size_t WS_NEED = OFF_CTB + (size_t)4 * NCH * 128 * 128 * 2;
static_assert(WS_NEED <= (size_t)512 * 1024 * 1024, "workspace too large");

struct Params {
    const float *x, *norm_g, *w_in, *b_in, *f_bias, *conv_w, *conv_b, *rel_bias, *c_norm_w, *w_branch, *w_out, *final_g;
    float* out; unsigned char* ws;
};

__device__ __forceinline__ int opaque_tid() { int t = threadIdx.x; asm volatile("" : "+v"(t)); return t; }
__device__ __forceinline__ unsigned char* opaque_ptr(unsigned char* p) { unsigned z = 0; asm volatile("" : "+s"(z)); return p + z; }
__device__ __forceinline__ u32 pk2(float a, float b) {
    __bf16 x = (__bf16)a, y = (__bf16)b;
    return (u32)__builtin_bit_cast(u16, x) | ((u32)__builtin_bit_cast(u16, y) << 16);
}
__device__ __forceinline__ u16 f2bf(float a) { __bf16 x = (__bf16)a; return __builtin_bit_cast(u16, x); }
__device__ __forceinline__ float bf2f(u16 v) { return __uint_as_float((u32)v << 16); }
__device__ __forceinline__ float bflo(u32 v) { return __uint_as_float(v << 16); }
__device__ __forceinline__ float bfhi(u32 v) { return __uint_as_float(v & 0xffff0000u); }
__device__ __forceinline__ bf8 ld_bf8(const void* p) { return *(const bf8*)p; }
__device__ __forceinline__ bf8 u4_to_bf8(uint4 u) { return __builtin_bit_cast(bf8, u); }
__device__ __forceinline__ f32x16 mfma32(bf8 a, bf8 b, f32x16 c) { return __builtin_amdgcn_mfma_f32_32x32x16_bf16(a, b, c, 0, 0, 0); }
__device__ __forceinline__ f32x4 mfma16(bf8 a, bf8 b, f32x4 c) { return __builtin_amdgcn_mfma_f32_16x16x32_bf16(a, b, c, 0, 0, 0); }
__device__ __forceinline__ float wave_sum(float v) {
#pragma unroll
    for (int o = 1; o < 64; o <<= 1) v += __shfl_xor(v, o);
    return v;
}
__device__ __forceinline__ float wave_max(float v) {
#pragma unroll
    for (int o = 1; o < 64; o <<= 1) v = fmaxf(v, __shfl_xor(v, o));
    return v;
}
__device__ __forceinline__ float relu_i(float x) { const int b = __float_as_int(x); return __int_as_float(b > 0 ? b : 0); }
__device__ __forceinline__ float sigmoidf(float x) { return 1.f / (1.f + __expf(-x)); }
__device__ __forceinline__ float siluf(float x) { return x / (1.f + __expf(-x)); }
__device__ __forceinline__ float logsigmoidf(float x) { return fminf(x, 0.f) - log1pf(__expf(-fabsf(x))); }
__device__ __forceinline__ s16x4 ds_tr(const void* p) {
    return __builtin_amdgcn_ds_read_tr16_b64_v4i16((s16x4 __attribute__((address_space(3)))*)(p));
}
__device__ __forceinline__ bf8 tr_pair(const unsigned char* p0, const unsigned char* p1) {
    s16x4 lo = ds_tr(p0), hi = ds_tr(p1);
    typedef short s16x8 __attribute__((ext_vector_type(8)));
    s16x8 r = {lo[0], lo[1], lo[2], lo[3], hi[0], hi[1], hi[2], hi[3]};
    return __builtin_bit_cast(bf8, r);
}
__device__ __forceinline__ bf8 pack8(float a, float b, float c, float d, float e, float f, float g, float h) {
    uint4 u; u.x = pk2(a, b); u.y = pk2(c, d); u.z = pk2(e, f); u.w = pk2(g, h);
    return __builtin_bit_cast(bf8, u);
}


#define XB_TMO      128
#define XB_XCNT(j)  (256  + 64 * (j))
#define XB_XSUB(j)  (1280 + 64 * (j))
#define XB_XGEN(j)  (2304 + 64 * (j))
#define XB_TOP      3328
#define XB_TOPGEN   3392
#define XCD_BAR_WORDS 3456
#define XB_SPIN_CAP (1u << 22)
#define LAS __attribute__((address_space(3)))
__device__ __forceinline__ unsigned xb_ld(unsigned* p)              { return __hip_atomic_load(p, __ATOMIC_RELAXED, __HIP_MEMORY_SCOPE_AGENT); }
__device__ __forceinline__ unsigned xb_add(unsigned* p, unsigned v) { return __hip_atomic_fetch_add(p, v, __ATOMIC_RELAXED, __HIP_MEMORY_SCOPE_AGENT); }
__device__ __forceinline__ unsigned xb_xcc_id() { return (unsigned)__builtin_amdgcn_s_getreg((3 << 11) | 20) & 0xFu; }
#define XB_SPIN(cond, bar) do { unsigned _sp = 0; while (cond) { __builtin_amdgcn_s_sleep(1); \
    if ((++_sp & 255u) == 0u) { if (xb_ld(&(bar)[XB_TMO])) break; if (_sp > XB_SPIN_CAP) { atomicAdd(&(bar)[XB_TMO], 1u); break; } } } } while (0)
struct XcdBarrier { unsigned* bar; unsigned x; volatile LAS unsigned* st; };
__device__ __forceinline__ XcdBarrier xcd_barrier_post(unsigned* bar, volatile LAS unsigned* st) {
    XcdBarrier b; b.bar = bar; b.x = xb_xcc_id(); b.st = st;
    if (threadIdx.x == 0) (void)xb_add(&bar[XB_XCNT(b.x)], 1u);
    return b;
}
__device__ __forceinline__ void xcd_barrier_complete(unsigned* bar, unsigned x, unsigned& nloc, unsigned& nx) {
    const unsigned G = gridDim.x * gridDim.y * gridDim.z;
    unsigned sum, cnt, mine, sp = 0u;
    for (;;) {
        sum = 0u; cnt = 0u; mine = 0u;
#pragma unroll
        for (unsigned j = 0; j < 16; ++j) { const unsigned c = xb_ld(&bar[XB_XCNT(j)]); sum += c; cnt += (c > 0u) ? 1u : 0u; mine = (j == x) ? c : mine; }
        if (sum == G) break;
        __builtin_amdgcn_s_sleep(1);
        if ((++sp & 255u) == 0u) { if (xb_ld(&bar[XB_TMO])) break; if (sp > XB_SPIN_CAP) { atomicAdd(&bar[XB_TMO], 1u); break; } }
    }
    nloc = mine > 0u ? mine : 1u; nx = cnt > 0u ? cnt : 1u;
}
__device__ __forceinline__ void xcd_barrier(const XcdBarrier& b) {
    asm volatile("s_waitcnt vmcnt(0)" ::: "memory");
    __syncthreads();
    if (threadIdx.x == 0) {
        unsigned* bar = b.bar;
        __builtin_amdgcn_s_waitcnt(0);
        unsigned nloc = b.st[0], nx = b.st[1];
        if (nloc == 0u) { xcd_barrier_complete(bar, b.x, nloc, nx); b.st[0] = nloc; b.st[1] = nx; }
        const unsigned old = xb_add(&bar[XB_XSUB(b.x)], 1u);
        const unsigned gen = old / nloc;
        if (old + 1u == (gen + 1u) * nloc) {
            __builtin_amdgcn_fence(__ATOMIC_RELEASE, "agent");
            asm volatile("s_waitcnt vmcnt(0)" ::: "memory");
            const unsigned og = xb_add(&bar[XB_TOP], 1u);
            const unsigned tg = og / nx;
            if (og + 1u == (tg + 1u) * nx) xb_add(&bar[XB_TOPGEN], 1u);
            else XB_SPIN(xb_ld(&bar[XB_TOPGEN]) == tg, bar);
            __builtin_amdgcn_fence(__ATOMIC_ACQUIRE, "agent");
            xb_add(&bar[XB_XGEN(b.x)], 1u);
            asm volatile("s_waitcnt vmcnt(0)" ::: "memory");
        } else {
            XB_SPIN(xb_ld(&bar[XB_XGEN(b.x)]) == gen, bar);
            __builtin_amdgcn_fence(__ATOMIC_ACQUIRE, "agent");
            asm volatile("s_waitcnt vmcnt(0)" ::: "memory");
        }
    }
    __syncthreads();
}

__device__ __forceinline__ int colmap1(int n) {
    if (n < 1088) return n;
    if (n < 5184) return n + 4;
    if (n < 6208) return n + 12;
    if (n < 6212) return 1088 + (n - 6208);
    if (n < 6216) return 5188 + (n - 6212);
    if (n < 6220) return 5192 + (n - 6216);
    return -1;
}
__device__ __forceinline__ void tr_item(const float* __restrict__ src, int ld, int kind, const float* __restrict__ gk, u16* __restrict__ dst,
                                        int K, int k0, int n0, float* tile) {
    const int tid = opaque_tid();
    const int nn = tid & 63, kk0 = tid >> 6;
    int sc = n0 + nn;
    if (kind == 0) sc = colmap1(sc); else if (kind == 1) sc = 6220 + sc;
#pragma unroll
    for (int j = 0; j < 8; ++j) {
        const int kk = kk0 + 8 * j; float v = 0.f;
        if (sc >= 0) { v = src[(size_t)(k0 + kk) * ld + sc]; if (gk) v *= gk[k0 + kk]; }
        tile[kk * 65 + nn] = v;
    }
    __syncthreads();
    const int n = tid >> 3, kg = tid & 7;
    float f[8];
#pragma unroll
    for (int j = 0; j < 8; ++j) f[j] = tile[(kg * 8 + j) * 65 + n];
    uint4 o; o.x = pk2(f[0], f[1]); o.y = pk2(f[2], f[3]); o.z = pk2(f[4], f[5]); o.w = pk2(f[6], f[7]);
    *(uint4*)(dst + (size_t)(n0 + n) * K + k0 + kg * 8) = o;
    __syncthreads();
}
__device__ __forceinline__ void sincos_tab(double a, float& s, float& c) {
    const double k = rint(a * 0.63661977236758134308);
    double r = fma(-k, 1.57079632679489655800e+00, a); r = fma(-k, 6.12323399573676603587e-17, r);
    const int qd = (int)((long long)k & 3);
    const double r2 = r * r;
    const double sp = r * (1.0 + r2 * (-1.0 / 6 + r2 * (1.0 / 120 + r2 * (-1.0 / 5040 + r2 * (1.0 / 362880 + r2 * (-1.0 / 39916800 + r2 * (1.0 / 6227020800.0)))))));
    const double cp = 1.0 + r2 * (-0.5 + r2 * (1.0 / 24 + r2 * (-1.0 / 720 + r2 * (1.0 / 40320 + r2 * (-1.0 / 3628800 + r2 * (1.0 / 479001600.0 + r2 * (-1.0 / 87178291200.0)))))));
    float sv, cv;
    if (qd == 0) { sv = (float)sp; cv = (float)cp; } else if (qd == 1) { sv = (float)cp; cv = (float)-sp; }
    else if (qd == 2) { sv = (float)-sp; cv = (float)-cp; } else { sv = (float)-cp; cv = (float)sp; }
    s = sv; c = cv;
}
__device__ __forceinline__ void phase_p0(const Params& p, unsigned char* smem) {
    unsigned char* ws_ = opaque_ptr(p.ws);
    float* tile = (float*)smem;
    u16* WT1 = (u16*)(ws_ + OFF_WT1); u16* WG = (u16*)(ws_ + OFF_WG); u16* WB = (u16*)(ws_ + OFF_WB); u16* WO = (u16*)(ws_ + OFF_WO);
    constexpr int I1 = 98 * 16, I2 = 48 * 16, I3 = 3 * 16 * 8, I4 = 16 * 16, IL = I1 + I2 + I3 + I4;
    for (int it = blockIdx.x; it < 2 * IL; it += gridDim.x) {
        const int l = it / IL; int r = it % IL;
        const float* g = p.norm_g + l * 1024;
        if (r < I1) { tr_item(p.w_in + (size_t)l * 1024 * INW, INW, 0, g, WT1 + (size_t)l * N1 * 1024, 1024, (r & 15) * 64, (r >> 4) * 64, tile); continue; } r -= I1;
        if (r < I2) { tr_item(p.w_in + (size_t)l * 1024 * INW, INW, 1, g, WG + (size_t)l * 3072 * 1024, 1024, (r & 15) * 64, (r >> 4) * 64, tile); continue; } r -= I2;
        if (r < I3) { const int nb = r / 128, rr = r % 128;
            tr_item(p.w_branch + ((size_t)(l * 3 + nb)) * 512 * 1024, 1024, 2, nullptr, WB + ((size_t)(l * 3 + nb)) * 1024 * 512, 512, (rr & 7) * 64, (rr >> 3) * 64, tile); continue; } r -= I3;
        tr_item(p.w_out + (size_t)l * 1024 * 1024, 1024, 2, nullptr, WO + (size_t)l * 1024 * 1024, 1024, (r & 15) * 64, (r >> 4) * 64, tile);
    }
    const int gt = blockIdx.x * 512 + opaque_tid(), ngt = gridDim.x * 512;
    float* B1 = (float*)(ws_ + OFF_B1); float* BG = (float*)(ws_ + OFF_BG);
    for (int i = gt; i < 2 * N1; i += ngt) { const int l = i / N1, n = i % N1; const int sc = colmap1(n);
        float v = sc >= 0 ? p.b_in[l * INW + sc] : 0.f; if (n >= 6216 && n < 6220) v += p.f_bias[l * 4 + (n - 6216)]; B1[i] = v; }
    for (int i = gt; i < 2 * 3072; i += ngt) { const int l = i / 3072, n = i % 3072; BG[i] = p.b_in[l * INW + 6220 + n]; }
    float2* CS = (float2*)(ws_ + OFF_CS);
    for (int i = gt; i < SEQ * 8; i += ngt) {
        const int pos = i >> 3, fi = i & 7;
        const float invf = 1.0f / powf(500000.0f, (float)fi * 2.0f / 16.0f);
        const float ang = (float)pos * invf;
        float s, c; sincos_tab((double)ang, s, c);
        CS[i] = make_float2(c, s);
    }
}
__device__ __forceinline__ void phase_px(const Params& p, const float* xsrc) {
    unsigned char* ws_ = opaque_ptr(p.ws);
    const int tid0 = opaque_tid(), lane = tid0 & 63, wave = tid0 >> 6;
    u16* XB = (u16*)(ws_ + OFF_XB); float* R = (float*)(ws_ + OFF_R);
    for (int row = blockIdx.x * 8 + wave; row < T_TOK; row += gridDim.x * 8) {
        const float4* xr = (const float4*)(xsrc + (size_t)row * DM);
        float4 v[4]; float s = 0.f;
#pragma unroll
        for (int j = 0; j < 4; ++j) { v[j] = xr[lane + 64 * j]; s += v[j].x * v[j].x + v[j].y * v[j].y + v[j].z * v[j].z + v[j].w * v[j].w; }
        s = wave_sum(s);
        if (lane == 0) R[row] = rsqrtf(s * (1.f / DM) + 1e-6f);
        uint2* o = (uint2*)(XB + (size_t)row * DM);
#pragma unroll
        for (int j = 0; j < 4; ++j) o[lane + 64 * j] = make_uint2(pk2(v[j].x, v[j].y), pk2(v[j].z, v[j].w));
    }
}
__device__ __forceinline__ void phase_pf(const Params& p) {
    unsigned char* ws_ = opaque_ptr(p.ws);
    const int tid0 = opaque_tid(), lane = tid0 & 63, wave = tid0 >> 6;
    for (int row = blockIdx.x * 8 + wave; row < T_TOK; row += gridDim.x * 8) {
        float4* xr = (float4*)(p.out + (size_t)row * DM);
        float4 v[4]; float s = 0.f;
#pragma unroll
        for (int j = 0; j < 4; ++j) { v[j] = xr[lane + 64 * j]; s += v[j].x * v[j].x + v[j].y * v[j].y + v[j].z * v[j].z + v[j].w * v[j].w; }
        s = wave_sum(s);
        const float r = rsqrtf(s * (1.f / DM) + 1e-6f);
        const float4* g = (const float4*)p.final_g;
#pragma unroll
        for (int j = 0; j < 4; ++j) { const float4 gg = g[lane + 64 * j]; float4 w; w.x = v[j].x * r * gg.x; w.y = v[j].y * r * gg.y; w.z = v[j].z * r * gg.z; w.w = v[j].w * r * gg.w; xr[lane + 64 * j] = w; }
    }
}

template <int MT>
__device__ __forceinline__ void gemm_compute(f32x16 (&acc)[MT][2], const unsigned char* sA, const unsigned char* sB) {
#pragma unroll
    for (int ks = 0; ks < 4; ++ks) {
        bf8 a[MT], b[2];
#pragma unroll
        for (int mt = 0; mt < MT; ++mt) a[mt] = ld_bf8(sA + mt * 32 * 144 + ks * 32);
#pragma unroll
        for (int nt = 0; nt < 2; ++nt) b[nt] = ld_bf8(sB + nt * 32 * 144 + ks * 32);
#pragma unroll
        for (int mt = 0; mt < MT; ++mt)
#pragma unroll
            for (int nt = 0; nt < 2; ++nt) acc[mt][nt] = mfma32(a[mt], b[nt], acc[mt][nt]);
    }
}
#define GEMM_GLOAD(S, KT) do { const int kk_ = (KT) * 64; \
    S##a0 = *(const uint4*)(ga + kk_); S##a1 = *(const uint4*)(ga + (size_t)64 * lda + kk_); \
    if (MT == 2) { S##a2 = *(const uint4*)(ga + (size_t)128 * lda + kk_); S##a3 = *(const uint4*)(ga + (size_t)192 * lda + kk_); } \
    S##b0 = *(const uint4*)(gb + kk_); S##b1 = *(const uint4*)(gb + (size_t)64 * ldb + kk_); } while (0)
#define GEMM_LSTORE(S, ST) do { unsigned char* pa_ = smem + (ST) * STAGE + lrow * 144 + lch * 16; unsigned char* pb_ = pa_ + BM * 144; \
    *(uint4*)(pa_) = S##a0; *(uint4*)(pa_ + 64 * 144) = S##a1; \
    if (MT == 2) { *(uint4*)(pa_ + 128 * 144) = S##a2; *(uint4*)(pa_ + 192 * 144) = S##a3; } \
    *(uint4*)(pb_) = S##b0; *(uint4*)(pb_ + 64 * 144) = S##b1; } while (0)
#define GEMM_DECL(MT_) \
    constexpr int MT = MT_; constexpr int BM = MT * 128; constexpr int STAGE = (BM + 128) * 144; \
    uint4 r0a0, r0a1, r0a2 = make_uint4(0, 0, 0, 0), r0a3 = r0a2, r0b0, r0b1, r1a0, r1a1, r1a2 = r0a2, r1a3 = r0a2, r1b0, r1b1; \
    const int lrow = tid0 >> 3, lch = tid0 & 7; \
    const int fr = (lane & 31) * 144 + (lane >> 5) * 16; \
    const unsigned char* sA0 = smem + (wm * (MT * 32)) * 144 + fr; \
    const unsigned char* sB0 = smem + BM * 144 + (wn * 64) * 144 + fr; \
    const u16* ga = nullptr; const u16* gb = nullptr; int lda = 0, ldb = 0;
#define GEMM_ISSUE(A_, LDA_, B_, LDB_) do { lda = (LDA_); ldb = (LDB_); ga = (A_) + (size_t)lrow * lda + lch * 8; gb = (B_) + (size_t)lrow * ldb + lch * 8; \
    GEMM_GLOAD(r0, 0); GEMM_GLOAD(r1, 1); } while (0)
#define GEMM_RUN(K_, ACC) do { const int nk = (K_) >> 6; GEMM_LSTORE(r0, 0); __syncthreads(); \
    _Pragma("unroll 1") for (int kt = 0; kt < nk; kt += 2) { \
        GEMM_GLOAD(r0, kt + 2 < nk ? kt + 2 : kt); \
        gemm_compute<MT>(ACC, sA0, sB0); \
        GEMM_LSTORE(r1, 1); __syncthreads(); \
        GEMM_GLOAD(r1, kt + 3 < nk ? kt + 3 : kt + 1); \
        gemm_compute<MT>(ACC, sA0 + STAGE, sB0 + STAGE); \
        GEMM_LSTORE(r0, 0); __syncthreads(); } } while (0)

namespace pg8 {
#define PG8_LAS __attribute__((address_space(3)))
typedef unsigned short bf16_t;
typedef __bf16 mbf8 __attribute__((ext_vector_type(8)));
typedef float f32x4 __attribute__((ext_vector_type(4)));
typedef unsigned u32x4 __attribute__((ext_vector_type(4)));
constexpr int BM = 256, BK = 64, HALF = 128, HTB = HALF * BK * 2, STAGE_BYTES = 8 * HTB, NXCD = 8, WGM = 8;
__host__ __device__ __forceinline__ int lds_byte(int r, int c) { const int st = (r >> 4) * 2 + (c >> 5), rr = r & 15, cc = c & 31, ob = rr * 64 + cc * 2; return st * 1024 + (ob ^ (((ob >> 9) & 1) << 5)); }
__host__ __device__ __forceinline__ void stage_rc(int b, int& R, int& C) { const int st = b / 1024, sb = b % 1024, swz = sb ^ (((sb >> 9) & 1) << 5); R = (st >> 1) * 16 + swz / 64; C = (st & 1) * 32 + (swz % 64) / 2; }
__host__ __device__ __forceinline__ int perm32(int rho) { const int n = rho >> 4, i = rho & 15; return 8 * (i >> 2) + 4 * n + (i & 3); }
struct Unit { int pm, pn, seg; };
struct Gemm { const bf16_t* A; const bf16_t* Bt; int lda, ldb, K; size_t segA, segB; };
struct StaticOrder {
    int nM, nN, nwg, G, c;
    __device__ void init(int M, int N, int G_, int c_) { nM = M / BM; nN = N / BM; nwg = nM * nN; G = G_; c = c_; }
    __device__ bool next(int i, Unit& u) const {
        const long L = (long)i * G + c; if (L >= nwg) return false;
        int wgid = (int)L; { const int q = nwg / NXCD, r = nwg % NXCD, xcd = wgid % NXCD, off = wgid / NXCD; wgid = (xcd < r ? xcd * (q + 1) : r * (q + 1) + (xcd - r) * q) + off; }
        const int nig = WGM * nN, gid = wgid / nig, fm = gid * WGM, gsz = (nM - fm) < WGM ? (nM - fm) : WGM;
        u.pm = fm + ((wgid % nig) % gsz); u.pn = (wgid % nig) / gsz; u.seg = 0; return true;
    }
};
template <class Epi, class Sched>
__device__ __forceinline__ void gemm_phase(PG8_LAS unsigned char* lds, const Gemm g, const Sched& S, const Epi& E) {
    const int tid = opaque_tid(), wid = __builtin_amdgcn_readfirstlane(tid >> 6), lane = tid & 63, wr = wid >> 2, wc = wid & 3, fr = lane & 15, fq = lane >> 4;
    const int nt = g.K / BK;
    unsigned voffA[2], voffB[2];
#pragma unroll
    for (int i = 0; i < 2; ++i) { int R, C; stage_rc(tid * 16 + i * 8192, R, C); const int Rb = Epi::PERM ? ((R & ~31) + perm32(R & 31)) : R;
        voffA[i] = (unsigned)(R * g.lda + C) * 2u; voffB[i] = (unsigned)(Rb * g.ldb + C) * 2u; }
    const size_t kstep = (size_t)(BK * 2);
    const size_t hstepA = (size_t)HALF * g.lda * 2, hstepB = (size_t)HALF * g.ldb * 2;
    const size_t tstepA = 2 * hstepA, tstepB = 2 * hstepB;
    const unsigned ldsw = (unsigned)wid * 1024u;
    const int aoff = lds_byte(wr * 64 + fr, fq * 8), boff = lds_byte(wc * 32 + fr, fq * 8);
#define PG8_SA(b, h) (((b) * 2 + (h)) * HTB)
#define PG8_SB(b, h) ((4 + (b) * 2 + (h)) * HTB)
#define PG8_STAGE(bufoff, gbase, voff) do { _Pragma("unroll") for (int _i = 0; _i < 2; ++_i) \
        __builtin_amdgcn_global_load_lds((const unsigned*)((const char*)(gbase) + (voff)[_i]), (PG8_LAS unsigned*)(lds + (bufoff) + ldsw + _i * 8192), 16, 0, 0); } while (0)
#define PG8_LDA(dst, b, h) do { _Pragma("unroll") for (int m = 0; m < 4; ++m) _Pragma("unroll") for (int k = 0; k < 2; ++k) dst[m][k] = *(const PG8_LAS mbf8*)(lds + PG8_SA(b, h) + aoff + m * 2048 + k * 1024); } while (0)
#define PG8_LDB(dst, b, h) do { _Pragma("unroll") for (int n = 0; n < 2; ++n) _Pragma("unroll") for (int k = 0; k < 2; ++k) dst[n][k] = *(const PG8_LAS mbf8*)(lds + PG8_SB(b, h) + boff + n * 2048 + k * 1024); } while (0)
#define PG8_MMA(ai, bj, At, Bt) do { __builtin_amdgcn_s_setprio(1); _Pragma("unroll") for (int m = 0; m < 4; ++m) _Pragma("unroll") for (int n = 0; n < 2; ++n) _Pragma("unroll") for (int k = 0; k < 2; ++k) \
        acc[ai][bj][m][n] = __builtin_amdgcn_mfma_f32_16x16x32_bf16(Bt[n][k], At[m][k], acc[ai][bj][m][n], 0, 0, 0); __builtin_amdgcn_s_setprio(0); } while (0)
#define PG8_WAIT_V(n) asm volatile("s_waitcnt vmcnt(" #n ")" ::: "memory")
#define PG8_WAIT_L(n) asm volatile("s_waitcnt lgkmcnt(" #n ")" ::: "memory")
#define PG8_BAR __builtin_amdgcn_s_barrier()
#define PG8_SCHED __builtin_amdgcn_sched_barrier(0)
    Unit cur, nxt; int ui = 0;
    if (!S.next(0, cur)) return;
    f32x4 acc[2][2][4][2];
#pragma unroll
    for (int a = 0; a < 2; ++a)
#pragma unroll
        for (int b = 0; b < 2; ++b)
#pragma unroll
            for (int m = 0; m < 4; ++m)
#pragma unroll
                for (int n = 0; n < 2; ++n) acc[a][b][m][n] = (f32x4){0.f, 0.f, 0.f, 0.f};
    mbf8 At[4][2], B0[2][2], B1[2][2];
    const char* cA = (const char*)g.A + (size_t)cur.seg * g.segA + (size_t)cur.pm * tstepA; const char* cB = (const char*)g.Bt + (size_t)cur.seg * g.segB + (size_t)cur.pn * tstepB;
    PG8_STAGE(PG8_SB(0, 0), cB, voffB); PG8_STAGE(PG8_SA(0, 0), cA, voffA); PG8_STAGE(PG8_SB(0, 1), cB + hstepB, voffB); PG8_STAGE(PG8_SA(0, 1), cA + hstepA, voffA);
    if (wr == 1) PG8_BAR;
    PG8_WAIT_V(4); PG8_BAR;
    PG8_STAGE(PG8_SB(1, 0), cB + kstep, voffB); PG8_STAGE(PG8_SA(1, 0), cA + kstep, voffA); PG8_STAGE(PG8_SB(1, 1), cB + hstepB + kstep, voffB);
    PG8_WAIT_V(6); PG8_BAR;
    for (;;) {
        const bool has_next = S.next(ui + 1, nxt);
        const char* nA = has_next ? (const char*)g.A + (size_t)nxt.seg * g.segA + (size_t)nxt.pm * tstepA : cA; const char* nB = has_next ? (const char*)g.Bt + (size_t)nxt.seg * g.segB + (size_t)nxt.pn * tstepB : cB;
        for (int t = 0; t < nt; t += 2) {
            const bool last = (t == nt - 2);
            const char* a1 = cA + (size_t)(t + 1) * kstep;
            const char* a2 = last ? nA : cA + (size_t)(t + 2) * kstep; const char* b2 = last ? nB : cB + (size_t)(t + 2) * kstep;
            const char* a3 = a2 + kstep; const char* b3 = b2 + kstep;
            PG8_LDB(B0, 0, 0); PG8_SCHED; PG8_LDA(At, 0, 0); PG8_STAGE(PG8_SA(1, 1), a1 + hstepA, voffA);
            PG8_WAIT_L(8); PG8_BAR; PG8_WAIT_L(0); PG8_MMA(0, 0, At, B0); PG8_BAR; PG8_SCHED;
            PG8_LDB(B1, 0, 1); PG8_STAGE(PG8_SB(0, 0), b2, voffB);
            PG8_BAR; PG8_WAIT_L(0); PG8_MMA(0, 1, At, B1); PG8_BAR;
            PG8_LDA(At, 0, 1); PG8_STAGE(PG8_SA(0, 0), a2, voffA);
            PG8_BAR; PG8_WAIT_L(0); PG8_MMA(1, 0, At, B0); PG8_BAR; PG8_SCHED;
            PG8_STAGE(PG8_SB(0, 1), b2 + hstepB, voffB);
            PG8_WAIT_V(6); PG8_BAR; PG8_MMA(1, 1, At, B1); PG8_BAR;
            PG8_LDB(B0, 1, 0); PG8_SCHED; PG8_LDA(At, 1, 0); PG8_STAGE(PG8_SA(0, 1), a2 + hstepA, voffA);
            PG8_WAIT_L(8); PG8_BAR; PG8_WAIT_L(0); PG8_MMA(0, 0, At, B0); PG8_BAR; PG8_SCHED;
            PG8_LDB(B1, 1, 1); PG8_STAGE(PG8_SB(1, 0), b3, voffB);
            PG8_BAR; PG8_WAIT_L(0); PG8_MMA(0, 1, At, B1); PG8_BAR;
            PG8_LDA(At, 1, 1); PG8_STAGE(PG8_SA(1, 0), a3, voffA);
            PG8_BAR; PG8_WAIT_L(0); PG8_MMA(1, 0, At, B0); PG8_BAR; PG8_SCHED;
            PG8_STAGE(PG8_SB(1, 1), b3 + hstepB, voffB);
            PG8_WAIT_V(6); PG8_BAR; PG8_MMA(1, 1, At, B1); PG8_BAR;
        }
        E(acc, cur, wr, wc, fr, fq);
        if (!has_next) break;
#pragma unroll
        for (int a = 0; a < 2; ++a)
#pragma unroll
            for (int b = 0; b < 2; ++b)
#pragma unroll
                for (int m = 0; m < 4; ++m)
#pragma unroll
                    for (int n = 0; n < 2; ++n) acc[a][b][m][n] = (f32x4){0.f, 0.f, 0.f, 0.f};
        cur = nxt; cA = nA; cB = nB; ++ui;
    }
    PG8_WAIT_V(0);
    if (wr == 0) PG8_BAR;
    PG8_BAR;
#undef PG8_SA
#undef PG8_SB
#undef PG8_STAGE
#undef PG8_LDA
#undef PG8_LDB
#undef PG8_MMA
#undef PG8_WAIT_V
#undef PG8_WAIT_L
#undef PG8_BAR
#undef PG8_SCHED
}
struct EpiResid {
    static constexpr bool PERM = false;
    const float* xc; float* xo;
    __device__ __forceinline__ void operator()(const f32x4 (&acc)[2][2][4][2], const Unit& u, int wr, int wc, int fr, int fq) const {
        const int row0 = u.pm * BM + wr * 64 + fr, col0 = u.pn * BM + wc * 32 + 4 * fq;
#pragma unroll
        for (int ai = 0; ai < 2; ++ai)
#pragma unroll
            for (int m = 0; m < 4; ++m) {
                const size_t ro = (size_t)(row0 + ai * HALF + m * 16) * 1024 + col0;
#pragma unroll
                for (int bj = 0; bj < 2; ++bj)
#pragma unroll
                    for (int n = 0; n < 2; ++n) { const f32x4 xv = *(const f32x4*)(xc + ro + bj * HALF + n * 16); *(f32x4*)(xo + ro + bj * HALF + n * 16) = xv + acc[ai][bj][m][n]; }
            }
    }
};
struct EpiG1 {
    static constexpr bool PERM = true;
    const float* R; const float* B1; const float2* CS; unsigned short* P; unsigned short* KVA; unsigned short* IK;
    __device__ __forceinline__ void operator()(const f32x4 (&acc)[2][2][4][2], const Unit& u, int wr, int wc, int fr, int fq) const {
        const int row0 = u.pm * BM + wr * 64 + fr;
#pragma unroll
        for (int bj = 0; bj < 2; ++bj) {
            const int cg = u.pn * BM + bj * HALF + wc * 32;
            const int col = cg + 8 * fq;
            const int c64 = cg & ~63;
            const bool rope = ((cg & 63) == 0) && (c64 < 640 || (c64 >= 768 && c64 < 1088));
            const bool kv8 = (c64 >= 512 && c64 < 768);
            unsigned short* dst; int pitch;
            if (c64 == 1024) { dst = IK + (col - 1024); pitch = 64; }
            else { dst = P + col; pitch = 6208; }
            const f32x4 b0 = *(const f32x4*)(B1 + col), b1 = *(const f32x4*)(B1 + col + 4);
#pragma unroll
            for (int ai = 0; ai < 2; ++ai)
#pragma unroll
                for (int m = 0; m < 4; ++m) {
                    const int row = row0 + ai * HALF + m * 16;
                    const float rs = R[row];
                    f32x4 v0 = acc[ai][bj][m][0] * rs + b0, v1 = acc[ai][bj][m][1] * rs + b1;
                    if (rope) {
                        f32x4 p0, p1;
#pragma unroll
                        for (int e = 0; e < 4; ++e) { p0[e] = __shfl_xor(v0[e], 16); p1[e] = __shfl_xor(v1[e], 16); }
                        if (fq < 2) {
                            const f32x4* cs = (const f32x4*)(CS + (size_t)row * 8);
                            const f32x4 c01 = cs[0], c23 = cs[1], c45 = cs[2], c67 = cs[3];
                            const float sg = fq == 0 ? -1.f : 1.f;
                            v0[0] = v0[0] * c01[0] + sg * p0[0] * c01[1]; v0[1] = v0[1] * c01[2] + sg * p0[1] * c01[3];
                            v0[2] = v0[2] * c23[0] + sg * p0[2] * c23[1]; v0[3] = v0[3] * c23[2] + sg * p0[3] * c23[3];
                            v1[0] = v1[0] * c45[0] + sg * p1[0] * c45[1]; v1[1] = v1[1] * c45[2] + sg * p1[1] * c45[3];
                            v1[2] = v1[2] * c67[0] + sg * p1[2] * c67[1]; v1[3] = v1[3] * c67[2] + sg * p1[3] * c67[3];
                        }
                    }
                    if (kv8) {
                        int w0 = __builtin_amdgcn_cvt_pk_fp8_f32(v0[0], v0[1], 0, false); w0 = __builtin_amdgcn_cvt_pk_fp8_f32(v0[2], v0[3], w0, true);
                        int w1 = __builtin_amdgcn_cvt_pk_fp8_f32(v1[0], v1[1], 0, false); w1 = __builtin_amdgcn_cvt_pk_fp8_f32(v1[2], v1[3], w1, true);
                        *(uint2*)((unsigned char*)KVA + (size_t)row * 256 + (col - 512)) = make_uint2((unsigned)w0, (unsigned)w1);
                    } else {
                        u32x4 w; w.x = pk2(v0[0], v0[1]); w.y = pk2(v0[2], v0[3]); w.z = pk2(v1[0], v1[1]); w.w = pk2(v1[2], v1[3]);
                        *(u32x4*)(dst + (size_t)row * pitch) = w;
                    }
                }
        }
    }
};
struct PairOrder {
    int G, c, gatecols;
    __device__ bool next(int i, Unit& u) const {
        const int jj = c + (i / 3) * G, n = i % 3;
        if (jj >= 256) return false;
        const int q = jj & 7, k = jj >> 3;
        const int pmv = q * 8 + (k >> 2), pnv = k & 3;
        u.pm = pmv; u.pn = gatecols ? n * 4 + pnv : pnv; u.seg = gatecols ? 0 : n; return true;
    }
};
struct EpiGate {
    static constexpr bool PERM = true;
    const float* R; const float* BG; unsigned short* GT;
    __device__ __forceinline__ void operator()(const f32x4 (&acc)[2][2][4][2], const Unit& u, int wr, int wc, int fr, int fq) const {
        const int row0 = u.pm * BM + wr * 64 + fr;
#pragma unroll
        for (int bj = 0; bj < 2; ++bj) {
            const int col = u.pn * BM + bj * HALF + wc * 32 + 8 * fq;
            const f32x4 b0 = *(const f32x4*)(BG + col), b1 = *(const f32x4*)(BG + col + 4);
#pragma unroll
            for (int ai = 0; ai < 2; ++ai)
#pragma unroll
                for (int m = 0; m < 4; ++m) {
                    const int row = row0 + ai * HALF + m * 16;
                    const float rs = R[row];
                    const f32x4 v0 = acc[ai][bj][m][0] * rs + b0, v1 = acc[ai][bj][m][1] * rs + b1;
                    u32x4 w; w.x = pk2(sigmoidf(v0[0]), sigmoidf(v0[1])); w.y = pk2(sigmoidf(v0[2]), sigmoidf(v0[3]));
                    w.z = pk2(sigmoidf(v1[0]), sigmoidf(v1[1])); w.w = pk2(sigmoidf(v1[2]), sigmoidf(v1[3]));
                    *(u32x4*)(GT + (size_t)row * 3072 + col) = w;
                }
        }
    }
};
struct EpiMerge {
    static constexpr bool PERM = true;
    const unsigned short* GT; unsigned short* MG;
    __device__ __forceinline__ void operator()(const f32x4 (&acc)[2][2][4][2], const Unit& u, int wr, int wc, int fr, int fq) const {
        const int row0 = u.pm * BM + wr * 64 + fr;
#pragma unroll
        for (int bj = 0; bj < 2; ++bj) {
            const int col = u.pn * BM + bj * HALF + wc * 32 + 8 * fq;
#pragma unroll
            for (int ai = 0; ai < 2; ++ai)
#pragma unroll
                for (int m = 0; m < 4; ++m) {
                    const int row = row0 + ai * HALF + m * 16;
                    const u32x4 gq = *(const u32x4*)(GT + (size_t)row * 3072 + u.seg * 1024 + col);
                    u32x4 pq = {0u, 0u, 0u, 0u};
                    if (u.seg > 0) pq = *(const u32x4*)(MG + (size_t)row * 1024 + col);
                    const f32x4 a0 = acc[ai][bj][m][0], a1 = acc[ai][bj][m][1];
                    u32x4 w;
                    w.x = pk2(bflo(pq.x) + bflo(gq.x) * a0[0], bfhi(pq.x) + bfhi(gq.x) * a0[1]);
                    w.y = pk2(bflo(pq.y) + bflo(gq.y) * a0[2], bfhi(pq.y) + bfhi(gq.y) * a0[3]);
                    w.z = pk2(bflo(pq.z) + bflo(gq.z) * a1[0], bfhi(pq.z) + bfhi(gq.z) * a1[1]);
                    w.w = pk2(bflo(pq.w) + bflo(gq.w) * a1[2], bfhi(pq.w) + bfhi(gq.w) * a1[3]);
                    *(u32x4*)(MG + (size_t)row * 1024 + col) = w;
                }
        }
    }
};
}

__device__ __forceinline__ void phase_g1(const Params& p, int l, int b, unsigned char* smem) {
    unsigned char* ws_ = opaque_ptr(p.ws);
    const int tid0 = opaque_tid(), lane = tid0 & 63, wave = tid0 >> 6, wm = wave >> 1, wn = wave & 1;
    const u16* XB = (const u16*)(ws_ + OFF_XB) + (size_t)b * SEQ * 1024;
    const u16* W = (const u16*)(ws_ + OFF_WT1) + (size_t)l * N1 * 1024;
    const float* R = (const float*)(ws_ + OFF_R) + b * SEQ;
    const float* B1 = (const float*)(ws_ + OFF_B1) + l * N1;
    const float2* CS = (const float2*)(ws_ + OFF_CS);
    u16* P = (u16*)(ws_ + OFF_P); u16* KVA = (u16*)(ws_ + OFF_KVA); u16* IK = (u16*)(ws_ + OFF_IK); float* SM = (float*)(ws_ + OFF_SM);
    {
        pg8::Gemm g; g.A = XB; g.Bt = W; g.lda = 1024; g.ldb = 1024; g.K = 1024; g.segA = 0; g.segB = 0;
        pg8::StaticOrder S; S.init(SEQ, 6144, (int)gridDim.x, (int)blockIdx.x);
        pg8::EpiG1 E; E.R = R; E.B1 = B1; E.CS = CS; E.P = P; E.KVA = KVA; E.IK = IK;
        pg8::gemm_phase((PG8_LAS unsigned char*)smem, g, S, E);
    }
    GEMM_DECL(2)
    if ((int)blockIdx.x < 64) GEMM_ISSUE(XB + (size_t)blockIdx.x * 256 * 1024, 1024, W + (size_t)48 * 128 * 1024, 1024);
    for (int tile = blockIdx.x; tile < 64; tile += gridDim.x) {
        const int tm = tile, tn = 48;
        f32x16 acc[2][2];
#pragma unroll
        for (int i = 0; i < 2; ++i)
#pragma unroll
            for (int j = 0; j < 2; ++j)
#pragma unroll
                for (int e = 0; e < 16; ++e) acc[i][j][e] = 0.f;
        GEMM_RUN(1024, acc);
        { const int nx = tile + gridDim.x; if (nx < 64) GEMM_ISSUE(XB + (size_t)nx * 256 * 1024, 1024, W + (size_t)48 * 128 * 1024, 1024); }
        unsigned char* wreg = smem + wave * (64 * 144);
        const int nb64 = tn * 128 + wn * 64;
#pragma unroll
        for (int nt = 0; nt < 2; ++nt) {
            const int nbase = nb64 + nt * 32;
            const int n = nbase + (lane & 31);
            const float bias = B1[n];
            const bool rope = ((nbase & 63) == 0) && (nbase < 640 || (nbase >= 768 && nbase < 1088));
#pragma unroll
            for (int mt = 0; mt < 2; ++mt) {
#pragma unroll
                for (int reg = 0; reg < 16; ++reg) {
                    const int rl = mt * 32 + (reg & 3) + 8 * (reg >> 2) + 4 * (lane >> 5);
                    const int row = tm * 256 + wm * 64 + rl;
                    float v = acc[mt][nt][reg] * R[row] + bias;
                    if (rope) {
                        const float pv = __shfl_xor(v, 8);
                        if ((lane & 31) < 16) {
                            const float2 cs = CS[row * 8 + (lane & 7)];
                            v = ((lane & 31) < 8) ? (v * cs.x - pv * cs.y) : (v * cs.x + pv * cs.y);
                        }
                    }
                    if (nbase < 6208) *(u16*)(wreg + rl * 144 + (nt * 32 + (lane & 31)) * 2) = f2bf(v);
                    else if (n < 6220) SM[(size_t)row * 16 + (n - 6208)] = v;
                }
                __builtin_amdgcn_sched_barrier(0);
            }
        }
        __builtin_amdgcn_fence(__ATOMIC_RELEASE, "workgroup");
        __builtin_amdgcn_wave_barrier();
        __builtin_amdgcn_fence(__ATOMIC_ACQUIRE, "workgroup");
        if (nb64 < 6208) {
            u16* dst; int pitch;
            if (nb64 >= 512 && nb64 < 768) { dst = KVA + (nb64 - 512); pitch = 256; }
            else if (nb64 == 1024) { dst = IK; pitch = 64; }
            else { dst = P + nb64; pitch = PLD; }
            const int ch = lane & 7;
#pragma unroll
            for (int i = 0; i < 8; ++i) {
                const int rl = (lane >> 3) + 8 * i;
                const uint4 d = *(const uint4*)(wreg + rl * 144 + ch * 16);
                *(uint4*)(dst + (size_t)(tm * 256 + wm * 64 + rl) * pitch + ch * 8) = d;
            }
        }
        __syncthreads();
    }
}
__device__ __forceinline__ void phase_g2(const Params& p, int l, int b, unsigned char* smem) {
    unsigned char* ws_ = opaque_ptr(p.ws);
    u16* GT = (u16*)(ws_ + OFF_P);
    {
        pg8::Gemm g; g.A = (const u16*)(ws_ + OFF_XB) + (size_t)b * SEQ * 1024; g.Bt = (const u16*)(ws_ + OFF_WG) + (size_t)l * 3072 * 1024;
        g.lda = 1024; g.ldb = 1024; g.K = 1024; g.segA = 0; g.segB = 0;
        pg8::PairOrder S; S.G = (int)gridDim.x; S.c = (int)blockIdx.x; S.gatecols = 1;
        pg8::EpiGate E; E.R = (const float*)(ws_ + OFF_R) + b * SEQ; E.BG = (const float*)(ws_ + OFF_BG) + l * 3072; E.GT = GT;
        pg8::gemm_phase((PG8_LAS unsigned char*)smem, g, S, E);
    }
    {
        pg8::Gemm g; g.A = (const u16*)(ws_ + OFF_YBR); g.Bt = (const u16*)(ws_ + OFF_WB) + (size_t)l * 3 * 1024 * 512;
        g.lda = 1536; g.ldb = 512; g.K = 512; g.segA = 512 * 2; g.segB = (size_t)1024 * 512 * 2;
        pg8::PairOrder S; S.G = (int)gridDim.x; S.c = (int)blockIdx.x; S.gatecols = 0;
        pg8::EpiMerge E; E.GT = GT; E.MG = (u16*)(ws_ + OFF_MG);
        pg8::gemm_phase((PG8_LAS unsigned char*)smem, g, S, E);
    }
}

__device__ __forceinline__ void phase_g3(const Params& p, int l, int b, unsigned char* smem) {
    unsigned char* ws_ = opaque_ptr(p.ws);
    pg8::Gemm g; g.A = (const u16*)(ws_ + OFF_MG); g.Bt = (const u16*)(ws_ + OFF_WO) + (size_t)l * 1024 * 1024; g.lda = 1024; g.ldb = 1024; g.K = 1024; g.segA = 0; g.segB = 0;
    pg8::StaticOrder S; S.init(SEQ, 1024, (int)gridDim.x, (int)blockIdx.x);
    pg8::EpiResid E; E.xc = (l == 0 ? p.x : p.out) + (size_t)b * SEQ * 1024; E.xo = p.out + (size_t)b * SEQ * 1024;
    pg8::gemm_phase((PG8_LAS unsigned char*)smem, g, S, E);
}

constexpr int HST = 257;
constexpr int CAP = 256;
constexpr int A_HIST = 0, A_HISTF = 33280, A_HIST2 = 66560, A_CKEY = 0, A_CIDX = 32768, A_PL = 0, A_SEL = 99840, A_ST = A_SEL + 16384, A_FLAG = A_ST + 2048, A_BQ = A_FLAG + 1024;
static_assert(32 * HST * 4 <= A_HISTF && A_HIST2 + 32 * HST * 4 <= A_SEL && 8 * 8192 <= A_SEL && A_BQ + 8192 <= LDS_BYTES - 64, "a lds");
__device__ __forceinline__ void a_unit(const Params& p, int c, int hf, unsigned char* smem) {
    unsigned char* ws_ = opaque_ptr(p.ws);
    const int tid = opaque_tid(), lane = tid & 63, wave = tid >> 6;
    const int q = lane & 31, hh = lane >> 5;
    const u16* P = (const u16*)(ws_ + OFF_P); const u16* KVA = (const u16*)(ws_ + OFF_KVA); const u16* IK = (const u16*)(ws_ + OFF_IK);
    const float* SM = (const float*)(ws_ + OFF_SM); u16* YBR = (u16*)(ws_ + OFF_YBR);
    u32* hist = (u32*)(smem + A_HIST); u16* sel = (u16*)(smem + A_SEL); u32* ckey = (u32*)(smem + A_CKEY); u32* cidx = (u32*)(smem + A_CIDX);
    u32* st = (u32*)(smem + A_ST); u32* flag = (u32*)(smem + A_FLAG);
    const int t0 = c * 64 + hf * 32;
    const int nadm = 64 * (c + 1);
    for (int rep_sel = 0; rep_sel < DUP_ASEL; ++rep_sel) {
    __syncthreads();
    if (c < 4) {
        for (int i = tid; i < 32 * 256; i += 512) { const int s = i & 255; sel[i] = (u16)(s < nadm ? s : 0); }
    } else {
        const size_t tq = (size_t)(t0 + q);
        bf8 bq[4][4];
        float w[4];
        float ssq = 0.f;
#pragma unroll
        for (int h = 0; h < 4; ++h) {
            w[h] = SM[tq * 16 + h] * 0.0625f;
            float n2 = 0.f;
#pragma unroll
            for (int s = 0; s < 4; ++s) {
                const uint4 raw = *(const uint4*)(P + tq * PLD + C_IQ + h * 64 + s * 16 + hh * 8);
                bq[h][s] = u4_to_bf8(raw);
                n2 += bflo(raw.x) * bflo(raw.x) + bfhi(raw.x) * bfhi(raw.x) + bflo(raw.y) * bflo(raw.y) + bfhi(raw.y) * bfhi(raw.y)
                    + bflo(raw.z) * bflo(raw.z) + bfhi(raw.z) * bfhi(raw.z) + bflo(raw.w) * bflo(raw.w) + bfhi(raw.w) * bfhi(raw.w);
            }
            n2 += __shfl_xor(n2, 32);
            ssq += w[h] * w[h] * n2;
        }
        unsigned char* bql = smem + A_BQ + lane * 16;
        if (wave == 0) {
#pragma unroll
            for (int s = 0; s < 4; ++s) { *(bf8*)(bql + s * 1024) = bq[2][s]; *(bf8*)(bql + (4 + s) * 1024) = bq[3][s]; }
        }
        const float sdev = sqrtf(ssq);
        const float rsd = (sdev > 1e-30f) ? 1.f / sdev : 0.f;
        const float bS1 = 1024.f * rsd, bS2 = 256.f * rsd, bS3 = 64.f * rsd, bS4 = 16.f * rsd;
        const int nkt = 2 * (c + 1);
        if (tid < 32) { st[0 * 32 + tid] = 0; st[1 * 32 + tid] = 0; st[2 * 32 + tid] = 256; st[3 * 32 + tid] = 0; st[4 * 32 + tid] = 0; st[5 * 32 + tid] = 0; st[6 * 32 + tid] = 0; st[7 * 32 + tid] = 0; }
        auto load_tile = [&](int kt, bf8 (&a)[4]) {
            const u16* kr = IK + (size_t)(kt * 32 + q) * 64 + hh * 8;
#pragma unroll
            for (int s = 0; s < 4; ++s) a[s] = ld_bf8(kr + s * 16);
        };
        auto score_tile = [&](const bf8 (&a)[4], f32x16& sc) {
            f32x16 acc0, acc1;
#pragma unroll
            for (int e = 0; e < 16; ++e) { acc0[e] = 0.f; acc1[e] = 0.f; }
#pragma unroll
            for (int s = 0; s < 4; ++s) acc0 = mfma32(a[s], bq[0][s], acc0);
#pragma unroll
            for (int s = 0; s < 4; ++s) acc1 = mfma32(a[s], bq[1][s], acc1);
            __builtin_amdgcn_sched_barrier(0);
#pragma unroll
            for (int reg = 0; reg < 16; ++reg) sc[reg] = relu_i(acc0[reg]) * w[0];
#pragma unroll
            for (int e = 0; e < 16; ++e) acc0[e] = 0.f;
            {
                bf8 b2[4];
#pragma unroll
                for (int s = 0; s < 4; ++s) b2[s] = ld_bf8(bql + s * 1024);
#pragma unroll
                for (int s = 0; s < 4; ++s) acc0 = mfma32(a[s], b2[s], acc0);
            }
            __builtin_amdgcn_sched_barrier(0);
#pragma unroll
            for (int reg = 0; reg < 16; ++reg) sc[reg] = fmaf(relu_i(acc1[reg]), w[1], sc[reg]);
#pragma unroll
            for (int e = 0; e < 16; ++e) acc1[e] = 0.f;
            {
                bf8 b3[4];
#pragma unroll
                for (int s = 0; s < 4; ++s) b3[s] = ld_bf8(bql + (4 + s) * 1024);
#pragma unroll
                for (int s = 0; s < 4; ++s) acc1 = mfma32(a[s], b3[s], acc1);
            }
            __builtin_amdgcn_sched_barrier(0);
#pragma unroll
            for (int reg = 0; reg < 16; ++reg) sc[reg] = fmaf(relu_i(acc0[reg]), w[2], sc[reg]);
#pragma unroll
            for (int reg = 0; reg < 16; ++reg) sc[reg] = fmaf(relu_i(acc1[reg]), w[3], sc[reg]) + 0.0f;
        };
        auto bin_mag = [&](float v) -> float {
            const float a = fabsf(v);
            return fminf(fminf(fminf(a * bS1, fmaf(a, bS2, 18.f)), fminf(fmaf(a, bS3, 40.5f), fmaf(a, bS4, 64.125f))), 126.f);
        };
        auto bin_of = [&](float v) -> u32 {
            const u32 m = (u32)bin_mag(v);
            const int sg = __float_as_int(v) >> 31;
            return (u32)(128 + (int)(m ^ (u32)sg));
        };
        auto sub_of = [&](float v) -> u32 {
            const float a = fabsf(v);
            const float s = fminf(fminf(a * bS1, fmaf(a, bS2, 18.f)), fminf(fmaf(a, bS3, 40.5f), fmaf(a, bS4, 64.125f)));
            const float m = floorf(fminf(s, 126.f));
            int sb = (int)fminf((s - m) * 256.f, 255.f);
            return v > 0.f ? (u32)sb : (v < 0.f ? (u32)(255 - sb) : 0u);
        };
        u32* hist2 = (u32*)(smem + A_HIST2);
        int level = 0;
#pragma unroll 1
        for (;; ++level) {
            for (int i = tid; i < 32 * HST; i += 512) { hist[i] = 0; if (level == 0) hist2[i] = 0; }
            __syncthreads();
            const int sh = (level == 7) ? 0 : 54 - 8 * level;
            const int bits = (level == 7) ? 6 : 8;
            if (level == 0) {
              {
                bf8 an[4]; load_tile(wave < nkt ? wave : 0, an);
#pragma unroll 1
                for (int kt = wave; kt < nkt; kt += 8) {
                    bf8 ac[4];
#pragma unroll
                    for (int s = 0; s < 4; ++s) ac[s] = an[s];
                    load_tile(kt + 8 < nkt ? kt + 8 : kt, an);
                    f32x16 sc; score_tile(ac, sc);
                    u32 zc = 0;
#pragma unroll
                    for (int reg = 0; reg < 16; ++reg) {
                        atomicAdd(&hist[q * HST + bin_of(sc[reg])], 1u);
                        zc += (sc[reg] == 0.f) ? 1u : 0u;
                    }
                    if (zc) atomicAdd(&hist2[q * HST + (255u - (u32)(kt >> 1))], zc);
                }
              }
            } else {
                const u64 pref = ((u64)st[1 * 32 + q] << 32) | st[0 * 32 + q];
                const bool qdone = st[3 * 32 + q] != 0;
                const int sh_hi = sh + bits;
                const u32 dmask = (level == 7) ? 63u : 255u;
                bf8 an[4]; load_tile(wave < nkt ? wave : 0, an);
#pragma unroll 1
                for (int kt = wave; kt < nkt; kt += 8) {
                    bf8 ac[4];
#pragma unroll
                    for (int s = 0; s < 4; ++s) ac[s] = an[s];
                    load_tile(kt + 8 < nkt ? kt + 8 : kt, an);
                    f32x16 sc; score_tile(ac, sc);
#pragma unroll
                    for (int reg = 0; reg < 16; ++reg) {
                        const u32 u = __float_as_uint(sc[reg]);
                        const u32 key = (u & 0x80000000u) ? ~u : (u | 0x80000000u);
                        const u32 idx = kt * 32 + (reg & 3) + 8 * (reg >> 2) + 4 * hh;
                        const u64 K = ((u64)bin_of(sc[reg]) << 54) | ((u64)sub_of(sc[reg]) << 46) | ((u64)key << 14) | (u64)(16383u - idx);
                        if (!qdone && (K >> sh_hi) == pref) atomicAdd(&hist[q * HST + (u32)((K >> sh) & dmask)], 1u);
                    }
                }
            }
            __syncthreads();
            if (lane == 0) flag[wave] = 0;
            auto find_cross = [&](const u32* hrow, u32 r, u32& digit, u32& ac, u32& bucket) {
                uint4 h4; h4.x = hrow[lane * 4]; h4.y = hrow[lane * 4 + 1]; h4.z = hrow[lane * 4 + 2]; h4.w = hrow[lane * 4 + 3];
                const u32 s4 = h4.x + h4.y + h4.z + h4.w; u32 v = s4;
#pragma unroll
                for (int off = 1; off < 64; off <<= 1) { const u32 t = __shfl_down(v, off); if (lane + off < 64) v += t; }
                const u32 above = v - s4;
                const bool hit = above < r && r <= v;
                u32 a = above; u32 d, bk;
                if (a + h4.w >= r) { d = 3; bk = h4.w; }
                else { a += h4.w; if (a + h4.z >= r) { d = 2; bk = h4.z; }
                    else { a += h4.z; if (a + h4.y >= r) { d = 1; bk = h4.y; } else { a += h4.y; d = 0; bk = h4.x; } } }
                const u64 mk = __ballot(hit);
                const int src_lane = mk ? (__ffsll((long long)mk) - 1) : 0;
                digit = __shfl((u32)(lane * 4) + d, src_lane); ac = __shfl(a, src_lane); bucket = __shfl(bk, src_lane);
            };
#pragma unroll 1
            for (int j = 0; j < 4; ++j) {
                const int qq = 4 * wave + j;
                if (st[3 * 32 + qq] != 0) continue;
                const u32 r = st[2 * 32 + qq];
                u32 digit, ac, bucket;
                find_cross(hist + qq * HST, r, digit, ac, bucket);
                u32 pdig = digit;
                u32 shv = (u32)sh, rn = r - ac, cls = (level == 0) ? 0u : 2u;
                bool dn = (bucket <= (u32)CAP) || (level == 7);
                if (!dn && level == 0) {
                    if (digit == 128u) {
                        const u32* h2 = hist2 + qq * HST;
                        u32 nz = h2[lane * 4] + h2[lane * 4 + 1] + h2[lane * 4 + 2] + h2[lane * 4 + 3];
#pragma unroll
                        for (int off = 1; off < 64; off <<= 1) nz += __shfl_xor(nz, off);
                        const u32 npos = bucket - nz;
                        if (rn > npos) {
                            u32 d2, ac2, bk2;
                            find_cross(h2, rn - npos, d2, ac2, bk2);
                            pdig = d2; shv = 6u; rn = rn - npos - ac2; cls = 1u; dn = true;
                        }
                    }
                }
                if (lane == 0) {
                    u64 pf;
                    if (cls == 1u) pf = ((u64)128u << 48) | ((u64)0x80000000u << 8) | (u64)pdig;
                    else { pf = ((u64)st[1 * 32 + qq] << 32) | st[0 * 32 + qq]; pf = (pf << bits) | (u64)pdig; }
                    st[0 * 32 + qq] = (u32)pf; st[1 * 32 + qq] = (u32)(pf >> 32);
                    st[2 * 32 + qq] = rn; st[3 * 32 + qq] = dn ? 1u : 0u; st[6 * 32 + qq] = shv; st[7 * 32 + qq] = cls;
                    if (!dn) flag[wave] = 1;
                }
            }
            __syncthreads();
            u32 any = 0;
#pragma unroll
            for (int i = 0; i < 8; ++i) any |= flag[i];
            if (!any) break;
        }
        __syncthreads();
        {
            const u64 pref = ((u64)st[1 * 32 + q] << 32) | st[0 * 32 + q];
            const int shq = (int)st[6 * 32 + q];
            const u32 cls = st[7 * 32 + q];
            bf8 an[4]; load_tile(wave < nkt ? wave : 0, an);
            if (level == 0) {
                const bool cls1 = (cls == 1u);
                const u32 pb = cls1 ? 128u : (u32)pref;
                auto key_to_float = [&](u32 k) -> float { return __uint_as_float((k & 0x80000000u) ? (k ^ 0x80000000u) : ~k); };
                auto first_score_with_bin = [&](u32 B) -> float {
                    u32 lo = 0x007FFFFFu, hi = 0xFF800000u;
                    if (bin_of(key_to_float(hi)) < B) return __builtin_inff();
#pragma unroll 1
                    for (int it = 0; it < 32; ++it) {
                        if (lo >= hi) break;
                        const u32 mid = lo + ((hi - lo) >> 1);
                        if (bin_of(key_to_float(mid)) >= B) hi = mid; else lo = mid + 1;
                    }
                    return key_to_float(hi);
                };
                const float vs = cls1 ? 1.4e-45f : first_score_with_bin(pb + 1u);
                const float vc = cls1 ? __builtin_inff() : first_score_with_bin(pb);
                const u32 d2q = (u32)pref & 0xFFu;
#pragma unroll 1
                for (int kt = wave; kt < nkt; kt += 8) {
                    bf8 ac[4];
#pragma unroll
                    for (int s = 0; s < 4; ++s) ac[s] = an[s];
                    load_tile(kt + 8 < nkt ? kt + 8 : kt, an);
                    f32x16 sc; score_tile(ac, sc);
                    const u32 dgt = 255u - (u32)(kt >> 1);
                    const bool zsel = cls1 && dgt > d2q, zcand = cls1 && dgt == d2q;
                    u32 smask = 0;
#pragma unroll
                    for (int reg = 0; reg < 16; ++reg) {
                        const float v = sc[reg];
                        const bool z = (v == 0.f);
                        const bool s1 = (v >= vs) || (z && zsel);
                        const bool c1 = (!s1) && ((v >= vc) || (z && zcand));
                        smask |= s1 ? (1u << reg) : 0u;
                        if (c1) {
                            const u32 idx = kt * 32 + (reg & 3) + 8 * (reg >> 2) + 4 * hh;
                            const u32 pos = atomicAdd(&st[5 * 32 + q], 1u);
                            if (pos < (u32)CAP) { const u32 u = __float_as_uint(v); ckey[q * CAP + pos] = (u & 0x80000000u) ? ~u : (u | 0x80000000u); cidx[q * CAP + pos] = idx; }
                        }
                    }
                    if (smask) {
                        u32 pos = atomicAdd(&st[4 * 32 + q], (u32)__popc(smask));
                        while (smask) {
                            const int reg = __ffs((int)smask) - 1; smask &= smask - 1;
                            const u32 idx = kt * 32 + (reg & 3) + 8 * (reg >> 2) + 4 * hh;
                            if (pos < 256) sel[q * 256 + pos] = (u16)idx;
                            ++pos;
                        }
                    }
                }
            } else {
#pragma unroll 1
                for (int kt = wave; kt < nkt; kt += 8) {
                    bf8 ac[4];
#pragma unroll
                    for (int s = 0; s < 4; ++s) ac[s] = an[s];
                    load_tile(kt + 8 < nkt ? kt + 8 : kt, an);
                    f32x16 sc; score_tile(ac, sc);
#pragma unroll
                    for (int reg = 0; reg < 16; ++reg) {
                        const u32 u = __float_as_uint(sc[reg]);
                        const u32 key = (u & 0x80000000u) ? ~u : (u | 0x80000000u);
                        const u32 idx = kt * 32 + (reg & 3) + 8 * (reg >> 2) + 4 * hh;
                        const u64 K = ((u64)bin_of(sc[reg]) << 54) | ((u64)sub_of(sc[reg]) << 46) | ((u64)key << 14) | (u64)(16383u - idx);
                        const u64 e = K >> shq;
                        if (e >= pref) {
                            if (e > pref) { const u32 pos = atomicAdd(&st[4 * 32 + q], 1u); if (pos < 256) sel[q * 256 + pos] = (u16)idx; }
                            else { const u32 pos = atomicAdd(&st[5 * 32 + q], 1u); if (pos < (u32)CAP) { ckey[q * CAP + pos] = key; cidx[q * CAP + pos] = idx; } }
                        }
                    }
                }
            }
        }
        __syncthreads();
#pragma unroll 1
        for (int j = 0; j < 4; ++j) {
            const int qq = 4 * wave + j;
            const u32 nc = min(st[5 * 32 + qq], (u32)CAP), r = st[2 * 32 + qq];
            u32 ki[4], ii[4], rk[4];
#pragma unroll
            for (int t = 0; t < 4; ++t) { const u32 i = lane + 64 * t; ki[t] = i < nc ? ckey[qq * CAP + i] : 0u; ii[t] = i < nc ? cidx[qq * CAP + i] : 0xFFFFFFFFu; rk[t] = 0; }
            for (u32 jj = 0; jj < nc; ++jj) {
                const u32 kj = ckey[qq * CAP + jj], ij = cidx[qq * CAP + jj];
#pragma unroll
                for (int t = 0; t < 4; ++t) rk[t] += (kj > ki[t] || (kj == ki[t] && ij < ii[t])) ? 1u : 0u;
            }
#pragma unroll
            for (int t = 0; t < 4; ++t) {
                const u32 i = lane + 64 * t;
                if (i < nc && rk[t] < r) { const u32 pos = atomicAdd(&st[4 * 32 + qq], 1u); if (pos < 256) sel[qq * 256 + pos] = (u16)ii[t]; }
            }
        }
    }
    }
    __syncthreads();
    {
        u16* SELG = (u16*)(ws_ + OFF_SEL) + (size_t)t0 * 256;
        for (int i = tid; i < 32 * 256 / 8; i += 512) *(uint4*)(SELG + i * 8) = *(const uint4*)(sel + i * 8);
    }
    __syncthreads();
}

constexpr int T_SEL = 0, T_PL = 8 * 512;
__device__ __forceinline__ void att_unit(const Params& p, int c, int hf, int g, unsigned char* smem) {
    unsigned char* ws_ = opaque_ptr(p.ws);
    const int tid = opaque_tid(), lane = tid & 63, wave = tid >> 6;
    const u16* P = (const u16*)(ws_ + OFF_P); const unsigned char* KV8 = (const unsigned char*)(ws_ + OFF_KVA); u16* YBR = (u16*)(ws_ + OFF_YBR);
    const u16* SELG = (const u16*)(ws_ + OFF_SEL);
    const int t0 = c * 64 + hf * 32;
    const int nadm = 64 * (c + 1);
    const int nvalid = nadm < 256 ? nadm : 256;
    u16* selw = (u16*)(smem + T_SEL) + wave * 256;
    float* pl = (float*)(smem + T_PL) + wave * 1024;
    const int hc = lane & 15, lg = lane >> 4;
    __syncthreads();
    for (int rep_att = 0; rep_att < DUP_AATT; ++rep_att) {
#pragma unroll 1
    for (int j = 0; j < 4; ++j) {
        const size_t tq = (size_t)(t0 + 4 * wave + j);
        *(uint2*)(selw + lane * 4) = *(const uint2*)(SELG + tq * 256 + lane * 4);
        uint4 qn0 = make_uint4(0, 0, 0, 0), qn1 = qn0;
        if (hc < 4) { const u16* qp = P + tq * PLD + C_AQ + (g * 4 + hc) * 64 + lg * 8; qn0 = *(const uint4*)qp; qn1 = *(const uint4*)(qp + 32); }
        long bqa[2];
        {
            int a0 = __builtin_amdgcn_cvt_pk_fp8_f32(bflo(qn0.x), bfhi(qn0.x), 0, false); a0 = __builtin_amdgcn_cvt_pk_fp8_f32(bflo(qn0.y), bfhi(qn0.y), a0, true);
            int a1 = __builtin_amdgcn_cvt_pk_fp8_f32(bflo(qn0.z), bfhi(qn0.z), 0, false); a1 = __builtin_amdgcn_cvt_pk_fp8_f32(bflo(qn0.w), bfhi(qn0.w), a1, true);
            int c0 = __builtin_amdgcn_cvt_pk_fp8_f32(bflo(qn1.x), bfhi(qn1.x), 0, false); c0 = __builtin_amdgcn_cvt_pk_fp8_f32(bflo(qn1.y), bfhi(qn1.y), c0, true);
            int c1 = __builtin_amdgcn_cvt_pk_fp8_f32(bflo(qn1.z), bfhi(qn1.z), 0, false); c1 = __builtin_amdgcn_cvt_pk_fp8_f32(bflo(qn1.w), bfhi(qn1.w), c1, true);
            bqa[0] = (long)(((unsigned long long)(unsigned)a1 << 32) | (unsigned)a0);
            bqa[1] = (long)(((unsigned long long)(unsigned)c1 << 32) | (unsigned)c0);
        }
        __builtin_amdgcn_fence(__ATOMIC_RELEASE, "workgroup");
        __builtin_amdgcn_wave_barrier();
        __builtin_amdgcn_fence(__ATOMIC_ACQUIRE, "workgroup");
        const int ks = lane >> 3, dc = lane & 7;
        const unsigned char* vb = KV8 + 128 + g * 64 + dc * 8;
        uint2 vvs[16];
#pragma unroll
        for (int it = 0; it < 16; ++it) vvs[it] = *(const uint2*)(vb + (size_t)selw[it * 8 + ks] * 256);
        f32x4 sacc[16];
#pragma unroll
        for (int kt = 0; kt < 16; ++kt) {
            const u32 idx = selw[kt * 16 + hc];
            const unsigned char* kr = KV8 + (size_t)idx * 256 + g * 64 + lg * 8;
            const long a0 = *(const long*)kr, a1 = *(const long*)(kr + 32);
            f32x4 z = {0.f, 0.f, 0.f, 0.f};
            z = __builtin_amdgcn_mfma_f32_16x16x32_fp8_fp8(a0, bqa[0], z, 0, 0, 0);
            sacc[kt] = __builtin_amdgcn_mfma_f32_16x16x32_fp8_fp8(a1, bqa[1], z, 0, 0, 0);
        }
        float mx = -INFINITY;
#pragma unroll
        for (int kt = 0; kt < 16; ++kt)
#pragma unroll
            for (int r = 0; r < 4; ++r) {
                const int slot = kt * 16 + lg * 4 + r;
                const float v = slot < nvalid ? sacc[kt][r] * 0.125f : -INFINITY;
                sacc[kt][r] = v; mx = fmaxf(mx, v);
            }
        mx = fmaxf(mx, __shfl_xor(mx, 16)); mx = fmaxf(mx, __shfl_xor(mx, 32));
        float sum = 0.f;
#pragma unroll
        for (int kt = 0; kt < 16; ++kt)
#pragma unroll
            for (int r = 0; r < 4; ++r) { const float e = __expf(sacc[kt][r] - mx); sacc[kt][r] = e; sum += e; }
        sum += __shfl_xor(sum, 16); sum += __shfl_xor(sum, 32);
        const float inv = 1.f / sum;
        if (hc < 4) {
#pragma unroll
            for (int kt = 0; kt < 16; ++kt)
#pragma unroll
                for (int r = 0; r < 4; ++r) pl[(kt * 16 + lg * 4 + r) * 4 + hc] = sacc[kt][r] * inv;
        }
        __builtin_amdgcn_fence(__ATOMIC_RELEASE, "workgroup");
        __builtin_amdgcn_wave_barrier();
        __builtin_amdgcn_fence(__ATOMIC_ACQUIRE, "workgroup");
        {
            typedef float f32x2 __attribute__((ext_vector_type(2)));
            f32x2 o[4][4];
#pragma unroll
            for (int hq = 0; hq < 4; ++hq)
#pragma unroll
                for (int e = 0; e < 4; ++e) o[hq][e] = (f32x2){0.f, 0.f};
#pragma unroll
            for (int it = 0; it < 32; ++it) {
                const int n = it * 8 + ks;
                uint2 vv;
                if (it < 16) vv = vvs[it]; else vv = *(const uint2*)(vb + (size_t)selw[n] * 256);
                const float4 p4 = *(const float4*)&pl[n * 4];
                f32x2 v[4];
                v[0] = __builtin_amdgcn_cvt_pk_f32_fp8((int)vv.x, false); v[1] = __builtin_amdgcn_cvt_pk_f32_fp8((int)vv.x, true);
                v[2] = __builtin_amdgcn_cvt_pk_f32_fp8((int)vv.y, false); v[3] = __builtin_amdgcn_cvt_pk_f32_fp8((int)vv.y, true);
#pragma unroll
                for (int e = 0; e < 4; ++e) { o[0][e] += v[e] * p4.x; o[1][e] += v[e] * p4.y; o[2][e] += v[e] * p4.z; o[3][e] += v[e] * p4.w; }
            }
#pragma unroll
            for (int hq = 0; hq < 4; ++hq)
#pragma unroll
                for (int e = 0; e < 4; ++e) {
                    float t0 = o[hq][e].x, t1 = o[hq][e].y;
                    t0 += __shfl_xor(t0, 8); t0 += __shfl_xor(t0, 16); t0 += __shfl_xor(t0, 32);
                    t1 += __shfl_xor(t1, 8); t1 += __shfl_xor(t1, 16); t1 += __shfl_xor(t1, 32);
                    o[hq][e] = (f32x2){t0, t1};
                }
            if (ks < 4) {
                float r[8];
#pragma unroll
                for (int e = 0; e < 4; ++e) {
                    const f32x2 t = ks == 0 ? o[0][e] : (ks == 1 ? o[1][e] : (ks == 2 ? o[2][e] : o[3][e]));
                    r[2 * e] = t.x; r[2 * e + 1] = t.y;
                }
                const int col = (g * 4 + ks) * 64 + dc * 8;
                const uint4 zz = *(const uint4*)(P + tq * PLD + C_AZ + col);
                uint4 yy;
                yy.x = pk2(r[0] * siluf(bflo(zz.x)), r[1] * siluf(bfhi(zz.x))); yy.y = pk2(r[2] * siluf(bflo(zz.y)), r[3] * siluf(bfhi(zz.y)));
                yy.z = pk2(r[4] * siluf(bflo(zz.z)), r[5] * siluf(bfhi(zz.z))); yy.w = pk2(r[6] * siluf(bflo(zz.w)), r[7] * siluf(bfhi(zz.w)));
                *(uint4*)(YBR + tq * 1536 + col) = yy;
            }
        }
        __builtin_amdgcn_fence(__ATOMIC_RELEASE, "workgroup");
        __builtin_amdgcn_wave_barrier();
        __builtin_amdgcn_fence(__ATOMIC_ACQUIRE, "workgroup");
    }
    }
    __syncthreads();
}

constexpr int B_BIAS = 0, B_V = 8448;
__device__ __forceinline__ void b_unit(const Params& p, int l, int c, unsigned char* smem) {
    unsigned char* ws_ = opaque_ptr(p.ws);
    const int tid = opaque_tid(), lane = tid & 63, wave = tid >> 6;
    const int q = lane & 31, hh = lane >> 5;
    const u16* P = (const u16*)(ws_ + OFF_P); u16* YBR = (u16*)(ws_ + OFF_YBR);
    float* bt = (float*)(smem + B_BIAS);
    __syncthreads();
    for (int i = tid; i < 8 * 257; i += 512) bt[i] = p.rel_bias[l * 8 * 257 + i];
    __syncthreads();
    const int h = wave;
    const float* bth = bt + h * 257;
    unsigned char* vl = smem + B_V + wave * (64 * 144);
    const int tc = c * 64;
    bf8 bq[2][4];
#pragma unroll
    for (int nt = 0; nt < 2; ++nt)
#pragma unroll
        for (int ks = 0; ks < 4; ++ks) bq[nt][ks] = ld_bf8(P + (size_t)(tc + nt * 32 + q) * PLD + C_BQ + h * 64 + ks * 16 + hh * 8);
    f32x16 oacc[2][2];
#pragma unroll
    for (int i = 0; i < 2; ++i)
#pragma unroll
        for (int j = 0; j < 2; ++j)
#pragma unroll
            for (int e = 0; e < 16; ++e) oacc[i][j][e] = 0.f;
    float mrun[2] = {-INFINITY, -INFINITY}, lsum[2] = {0.f, 0.f};
    const int g16 = lane >> 4, i16 = lane & 15, qrow = i16 >> 2, pp = i16 & 3, hp = g16 >> 1;
#pragma unroll 1
    for (int kc = (c < 8 ? 8 - c : 0); kc <= 8; ++kc) {
        const int kch = c - 8 + kc;
#pragma unroll
        for (int i = 0; i < 8; ++i) {
            const int id = lane + 64 * i, row = id >> 3, ch = id & 7;
            *(uint4*)(vl + row * 144 + ch * 16) = *(const uint4*)(P + (size_t)(kch * 64 + row) * PLD + C_BV + h * 64 + ch * 8);
        }
        f32x16 s[2][2];
#pragma unroll
        for (int mt = 0; mt < 2; ++mt) {
            bf8 ak[4];
#pragma unroll
            for (int ks = 0; ks < 4; ++ks) ak[ks] = ld_bf8(P + (size_t)(kch * 64 + mt * 32 + q) * PLD + C_BK + h * 64 + ks * 16 + hh * 8);
#pragma unroll
            for (int nt = 0; nt < 2; ++nt) {
#pragma unroll
                for (int e = 0; e < 16; ++e) s[mt][nt][e] = 0.f;
#pragma unroll
                for (int ks = 0; ks < 4; ++ks) s[mt][nt] = mfma32(ak[ks], bq[nt][ks], s[mt][nt]);
            }
        }
#pragma unroll
        for (int nt = 0; nt < 2; ++nt) {
            const int qi = nt * 32 + q;
            float tmax = -INFINITY;
            if (kc <= 5) {
                const float bfar = bth[256];
#pragma unroll
                for (int mt = 0; mt < 2; ++mt)
#pragma unroll
                    for (int reg = 0; reg < 16; ++reg) { const float v = fmaf(s[mt][nt][reg], 0.125f, bfar); s[mt][nt][reg] = v; tmax = fmaxf(tmax, v); }
            } else {
#pragma unroll
                for (int mt = 0; mt < 2; ++mt)
#pragma unroll
                    for (int reg = 0; reg < 16; ++reg) {
                        const int kk = mt * 32 + (reg & 3) + 8 * (reg >> 2) + 4 * hh;
                        int rel = 512 + qi - (kc * 64 + kk);
                        rel = rel > 128 ? 128 : rel; rel = rel < -128 ? -128 : rel;
                        const float v = s[mt][nt][reg] * 0.125f + bth[rel + 128];
                        s[mt][nt][reg] = v; tmax = fmaxf(tmax, v);
                    }
            }
            tmax = fmaxf(tmax, __shfl_xor(tmax, 32));
            const float mnew = fmaxf(mrun[nt], tmax);
            const float alpha = __expf(mrun[nt] - mnew);
            mrun[nt] = mnew;
            float ps = 0.f;
#pragma unroll
            for (int mt = 0; mt < 2; ++mt)
#pragma unroll
                for (int reg = 0; reg < 16; ++reg) { const float e = __expf(s[mt][nt][reg] - mnew); s[mt][nt][reg] = e; ps += e; }
            lsum[nt] = lsum[nt] * alpha + ps;
#pragma unroll
            for (int dmt = 0; dmt < 2; ++dmt)
#pragma unroll
                for (int e = 0; e < 16; ++e) oacc[dmt][nt][e] *= alpha;
        }
        __builtin_amdgcn_fence(__ATOMIC_RELEASE, "workgroup");
        __builtin_amdgcn_wave_barrier();
        __builtin_amdgcn_fence(__ATOMIC_ACQUIRE, "workgroup");
#pragma unroll
        for (int mt = 0; mt < 2; ++mt)
#pragma unroll
            for (int sp = 0; sp < 2; ++sp) {
                const int rb = mt * 32 + 16 * sp + 4 * hp + qrow;
                bf8 av[2];
#pragma unroll
                for (int dmt = 0; dmt < 2; ++dmt) {
                    const unsigned char* a0 = vl + rb * 144 + (dmt * 32 + 16 * (g16 & 1) + 4 * pp) * 2;
                    av[dmt] = tr_pair(a0, a0 + 8 * 144);
                }
#pragma unroll
                for (int nt = 0; nt < 2; ++nt) {
                    const bf8 bp = pack8(s[mt][nt][8 * sp + 0], s[mt][nt][8 * sp + 1], s[mt][nt][8 * sp + 2], s[mt][nt][8 * sp + 3],
                                         s[mt][nt][8 * sp + 4], s[mt][nt][8 * sp + 5], s[mt][nt][8 * sp + 6], s[mt][nt][8 * sp + 7]);
#pragma unroll
                    for (int dmt = 0; dmt < 2; ++dmt) oacc[dmt][nt] = mfma32(av[dmt], bp, oacc[dmt][nt]);
                }
            }
        __builtin_amdgcn_fence(__ATOMIC_RELEASE, "workgroup");
        __builtin_amdgcn_wave_barrier();
        __builtin_amdgcn_fence(__ATOMIC_ACQUIRE, "workgroup");
    }
#pragma unroll
    for (int nt = 0; nt < 2; ++nt) {
        const float lt = lsum[nt] + __shfl_xor(lsum[nt], 32);
        const float inv = 1.f / lt;
        const size_t t = (size_t)(tc + nt * 32 + q);
#pragma unroll
        for (int dmt = 0; dmt < 2; ++dmt)
#pragma unroll
            for (int rg = 0; rg < 4; ++rg) {
                const int d0 = dmt * 32 + 8 * rg + 4 * hh;
                const uint2 zz = *(const uint2*)(P + t * PLD + C_BZ + h * 64 + d0);
                const float y0 = oacc[dmt][nt][4 * rg + 0] * inv * siluf(bflo(zz.x));
                const float y1 = oacc[dmt][nt][4 * rg + 1] * inv * siluf(bfhi(zz.x));
                const float y2 = oacc[dmt][nt][4 * rg + 2] * inv * siluf(bflo(zz.y));
                const float y3 = oacc[dmt][nt][4 * rg + 3] * inv * siluf(bfhi(zz.y));
                *(uint2*)(YBR + t * 1536 + 512 + h * 64 + d0) = make_uint2(pk2(y0, y1), pk2(y2, y3));
            }
    }
    __syncthreads();
}

__device__ __forceinline__ void conv8w(const u16* __restrict__ P, int t, int col, const float* __restrict__ cwl, const float* __restrict__ cbl, int cch, float (&out)[8]) {
    {
        const float4 a = *(const float4*)(cbl + cch), b = *(const float4*)(cbl + cch + 4);
        out[0] = a.x; out[1] = a.y; out[2] = a.z; out[3] = a.w; out[4] = b.x; out[5] = b.y; out[6] = b.z; out[7] = b.w;
    }
#pragma unroll
    for (int j = 0; j < 4; ++j) {
        const int tr = t - 3 + j;
        if (tr >= 0) {
            const float4 a = *(const float4*)(cwl + j * 1024 + cch), b = *(const float4*)(cwl + j * 1024 + cch + 4);
            const uint4 rw = *(const uint4*)(P + (size_t)tr * PLD + col);
            out[0] = fmaf(a.x, bflo(rw.x), out[0]); out[1] = fmaf(a.y, bfhi(rw.x), out[1]);
            out[2] = fmaf(a.z, bflo(rw.y), out[2]); out[3] = fmaf(a.w, bfhi(rw.y), out[3]);
            out[4] = fmaf(b.x, bflo(rw.z), out[4]); out[5] = fmaf(b.y, bfhi(rw.z), out[5]);
            out[6] = fmaf(b.z, bflo(rw.w), out[6]); out[7] = fmaf(b.w, bfhi(rw.w), out[7]);
        }
    }
#pragma unroll
    for (int e = 0; e < 8; ++e) out[e] = siluf(out[e]);
}
__device__ __forceinline__ float scan_sum64(float v, int lane) {
#pragma unroll
    for (int o = 1; o < 64; o <<= 1) { const float t = __shfl_up(v, o); if (lane >= o) v += t; }
    return v;
}
__device__ __forceinline__ float scan_max64(float v, int lane) {
#pragma unroll
    for (int o = 1; o < 64; o <<= 1) { const float t = __shfl_up(v, o); if (lane >= o) v = fmaxf(v, t); }
    return v;
}
constexpr int ROWB = 288;
constexpr int C1_TW = 0, C1_K = 1024, C1_V = 1024 + 2 * 64 * ROWB;
__device__ __forceinline__ void c1_unit(const Params& p, int l, int c, unsigned char* smem) {
    unsigned char* ws_ = opaque_ptr(p.ws);
    const int tid = opaque_tid(), lane = tid & 63, wave = tid >> 6;
    const u16* P = (const u16*)(ws_ + OFF_P); const float* SM = (const float*)(ws_ + OFF_SM);
    float* KVS = (float*)(ws_ + OFF_KVS); float* NS = (float*)(ws_ + OFF_NS); float* GC = (float*)(ws_ + OFF_GC); float* ML = (float*)(ws_ + OFF_ML);
    const float* cwl = p.conv_w + (size_t)l * 4 * 1024; const float* cbl = p.conv_b + (size_t)l * 1024;
    float* tw = (float*)(smem + C1_TW);
    const int tc = c * 64;
    const int g16 = lane >> 4, i16 = lane & 15, qrow = i16 >> 2, pp = i16 & 3, hp = g16 >> 1;
#pragma unroll 1
    for (int hpair = 0; hpair < 2; ++hpair) {
        __syncthreads();
        if ((wave & 3) == 0) {
            const int hl = wave >> 2, h = 2 * hpair + hl;
            const float fpre = SM[(size_t)(tc + lane) * 16 + 8 + h], ipre = SM[(size_t)(tc + lane) * 16 + 4 + h];
            const float bcum = scan_sum64(logsigmoidf(fpre), lane);
            const float u = ipre - bcum;
            const float umax = wave_max(u);
            tw[hl * 64 + lane] = __expf(u - umax);
            if (lane == 63) { GC[h * NCH + c] = bcum; ML[h * NCH + c] = bcum + umax; }
        }
        __syncthreads();
#pragma unroll 1
        for (int i = 0; i < 4; ++i) {
            const int item = tid + 512 * i, hl = item >> 10, row = (item >> 4) & 63, ch = item & 15, h = 2 * hpair + hl;
            float o[8];
            conv8w(P, tc + row, C_CK + h * 128 + ch * 8, cwl, cbl, 512 + h * 128 + ch * 8, o);
            {
                u16* KC = (u16*)(ws_ + OFF_MG) + (size_t)SEQ * 512; u16* QC = (u16*)(ws_ + OFF_MG);
                uint4 kc; kc.x = pk2(o[0], o[1]); kc.y = pk2(o[2], o[3]); kc.z = pk2(o[4], o[5]); kc.w = pk2(o[6], o[7]);
                *(uint4*)(KC + (size_t)(tc + row) * 512 + h * 128 + ch * 8) = kc;
                float oq[8];
                conv8w(P, tc + row, C_CQ + h * 128 + ch * 8, cwl, cbl, h * 128 + ch * 8, oq);
                const float qs = 0.08838834764831845f;
                uint4 qc; qc.x = pk2(oq[0] * qs, oq[1] * qs); qc.y = pk2(oq[2] * qs, oq[3] * qs); qc.z = pk2(oq[4] * qs, oq[5] * qs); qc.w = pk2(oq[6] * qs, oq[7] * qs);
                *(uint4*)(QC + (size_t)(tc + row) * 512 + h * 128 + ch * 8) = qc;
            }
            const float wg = tw[hl * 64 + row];
            uint4 kk; kk.x = pk2(o[0] * wg, o[1] * wg); kk.y = pk2(o[2] * wg, o[3] * wg); kk.z = pk2(o[4] * wg, o[5] * wg); kk.w = pk2(o[6] * wg, o[7] * wg);
            *(uint4*)(smem + C1_K + hl * 64 * ROWB + row * ROWB + ch * 16) = kk;
            *(uint4*)(smem + C1_V + hl * 64 * ROWB + row * ROWB + ch * 16) = *(const uint4*)(P + (size_t)(tc + row) * PLD + C_CV + h * 128 + ch * 8);
        }
        __syncthreads();
        {
            const int hl = wave >> 2, ws = wave & 3, h = 2 * hpair + hl;
            const unsigned char* kb = smem + C1_K + hl * 64 * ROWB; const unsigned char* vb = smem + C1_V + hl * 64 * ROWB;
            f32x16 acc[5];
#pragma unroll
            for (int i = 0; i < 5; ++i)
#pragma unroll
                for (int e = 0; e < 16; ++e) acc[i][e] = 0.f;
            const bf8 ones = pack8(1.f, 1.f, 1.f, 1.f, 1.f, 1.f, 1.f, 1.f), zeros = pack8(0.f, 0.f, 0.f, 0.f, 0.f, 0.f, 0.f, 0.f);
            const bf8 aext = ((lane & 31) == 0) ? ones : zeros;
#pragma unroll
            for (int ks = 0; ks < 4; ++ks) {
                const int rb = 16 * ks + 8 * hp + qrow;
                const unsigned char* b0 = kb + rb * ROWB + (32 * ws + 16 * (g16 & 1) + 4 * pp) * 2;
                const bf8 bfr = tr_pair(b0, b0 + 4 * ROWB);
#pragma unroll
                for (int emt = 0; emt < 4; ++emt) {
                    const unsigned char* a0 = vb + rb * ROWB + (32 * emt + 16 * (g16 & 1) + 4 * pp) * 2;
                    const bf8 afr = tr_pair(a0, a0 + 4 * ROWB);
                    acc[emt] = mfma32(afr, bfr, acc[emt]);
                }
                acc[4] = mfma32(aext, bfr, acc[4]);
            }
            float* ct = KVS + ((size_t)(h * NCH + c) * 128) * 128;
            const int d = 32 * ws + (lane & 31);
#pragma unroll
            for (int emt = 0; emt < 4; ++emt)
#pragma unroll
                for (int reg = 0; reg < 16; ++reg) {
                    const int e = emt * 32 + (reg & 3) + 8 * (reg >> 2) + 4 * (lane >> 5);
                    ct[(size_t)e * 128 + d] = acc[emt][reg];
                }
            if ((lane >> 5) == 0) NS[(size_t)(h * NCH + c) * 128 + d] = acc[4][0];
        }
    }
    __syncthreads();
}
__device__ __forceinline__ void m2_unit(const Params& p, int item, unsigned char* smem) {
    unsigned char* ws_ = opaque_ptr(p.ws);
    const int tid = opaque_tid();
    float* KVS = (float*)(ws_ + OFF_KVS); float* NS = (float*)(ws_ + OFF_NS);
    const float* GC = (const float*)(ws_ + OFF_GC); const float* ML = (const float*)(ws_ + OFF_ML); float* MP = (float*)(ws_ + OFF_MP);
    float* sa = (float*)smem; float* sb = sa + 1024;
    {
        __syncthreads();
        for (int i = tid; i < 1024; i += 512) { sa[i] = GC[i]; sb[i] = ML[i]; }
        __syncthreads();
        if (tid < 4) {
            const int h = tid; float m = 0.f;
            for (int c = 0; c < NCH; ++c) {
                const float g = sa[h * NCH + c], ml = sb[h * NCH + c];
                const float mn = fmaxf(g + m, ml);
                sa[h * NCH + c] = __expf(g + m - mn); sb[h * NCH + c] = __expf(ml - mn);
                if (item == 256) MP[h * NCH + c] = m;
                m = mn;
            }
        }
        __syncthreads();
        if (item < 256) {
            if (tid < 256) {
                const int h = item >> 6, idx = (item & 63) * 256 + tid;
                float* base = KVS + (size_t)h * NCH * 16384 + idx;
                u16* baseb = (u16*)(ws_ + OFF_CTB) + (size_t)h * NCH * 16384 + idx;
                const float* a = sa + h * NCH; const float* bb = sb + h * NCH;
                float C = 0.f;
#pragma unroll 1
                for (int c0 = 0; c0 < NCH; c0 += 32) {
                    float kv[32];
#pragma unroll
                    for (int j = 0; j < 32; ++j) kv[j] = base[(size_t)(c0 + j) * 16384];
#pragma unroll
                    for (int j = 0; j < 32; ++j) { baseb[(size_t)(c0 + j) * 16384] = f2bf(C); C = a[c0 + j] * C + bb[c0 + j] * kv[j]; }
                }
            }
        } else {
            const int h = tid >> 7, d = tid & 127;
            float* base = NS + (size_t)h * NCH * 128 + d;
            float n = 0.f;
#pragma unroll 1
            for (int c0 = 0; c0 < NCH; c0 += 16) {
                float ks[16];
#pragma unroll
                for (int j = 0; j < 16; ++j) ks[j] = base[(size_t)(c0 + j) * 128];
#pragma unroll
                for (int j = 0; j < 16; ++j) { base[(size_t)(c0 + j) * 128] = n; n = sa[h * NCH + c0 + j] * n + sb[h * NCH + c0 + j] * ks[j]; }
            }
        }
    }
    __syncthreads();
}
constexpr int C3_V = 0, C3_TB = 4 * 64 * ROWB, C3_BQ = C3_TB + 8 * 768;
static_assert(C3_BQ + 8 * 8192 <= LDS_BYTES, "c3 lds");
__device__ __forceinline__ void c3_unit(const Params& p, int l, int c, unsigned char* smem) {
    unsigned char* ws_ = opaque_ptr(p.ws);
    const int tid = opaque_tid(), lane = tid & 63, wave = tid >> 6;
    const int q = lane & 31, hh = lane >> 5;
    const u16* P = (const u16*)(ws_ + OFF_P); const float* SM = (const float*)(ws_ + OFF_SM); u16* YBR = (u16*)(ws_ + OFF_YBR);
    const float* KVS = (const float*)(ws_ + OFF_KVS); const float* NS = (const float*)(ws_ + OFF_NS); const float* MP = (const float*)(ws_ + OFF_MP);
    const float* cwl = p.conv_w + (size_t)l * 4 * 1024; const float* cbl = p.conv_b + (size_t)l * 1024;
    const int tc = c * 64;
    const int h = wave >> 1, qh = wave & 1;
    __syncthreads();
#pragma unroll 1
    for (int i = 0; i < 8; ++i) {
        const int item = tid + 512 * i, hv = item >> 10, row = (item >> 4) & 63, ch = item & 15;
        *(uint4*)(smem + C3_V + hv * 64 * ROWB + row * ROWB + ch * 16) = *(const uint4*)(P + (size_t)(tc + row) * PLD + C_CV + hv * 128 + ch * 8);
    }
    float* tb = (float*)(smem + C3_TB) + wave * 192; float* tu = tb + 64; float* tcm = tb + 128;
    const float mprev = MP[h * NCH + c];
    {
        const float fpre = SM[(size_t)(tc + lane) * 16 + 8 + h], ipre = SM[(size_t)(tc + lane) * 16 + 4 + h];
        const float bcum = scan_sum64(logsigmoidf(fpre), lane);
        const float u = ipre - bcum;
        const float cm = fmaxf(scan_max64(u, lane), mprev);
        tb[lane] = bcum; tu[lane] = u; tcm[lane] = cm;
    }
    __syncthreads();
    const int lq = qh * 32 + q;
    const float cmq = tcm[lq], bq_ = tb[lq];
    const u16* QC = (const u16*)(ws_ + OFF_MG) + (size_t)(tc + lq) * 512 + h * 128 + hh * 8;
    const u16* KC = (const u16*)(ws_ + OFF_MG) + (size_t)SEQ * 512 + (size_t)(tc + q) * 512 + h * 128 + hh * 8;
    f32x16 xacc[2];
#pragma unroll
    for (int i = 0; i < 2; ++i)
#pragma unroll
        for (int e = 0; e < 16; ++e) xacc[i][e] = 0.f;
#pragma unroll
    for (int ks = 0; ks < 8; ++ks) {
        const bf8 bqv = ld_bf8(QC + ks * 16);
#pragma unroll
        for (int mt = 0; mt < 2; ++mt) xacc[mt] = mfma32(ld_bf8(KC + (size_t)mt * 32 * 512 + ks * 16), bqv, xacc[mt]);
    }
#pragma unroll
    for (int mt = 0; mt < 2; ++mt)
#pragma unroll
        for (int reg = 0; reg < 16; ++reg) {
            const int s = mt * 32 + (reg & 3) + 8 * (reg >> 2) + 4 * hh;
            const float wgt = (s <= lq) ? __expf(tu[s] - cmq) : 0.f;
            xacc[mt][reg] *= wgt;
        }
    f32x16 num[5];
#pragma unroll
    for (int i = 0; i < 5; ++i)
#pragma unroll
        for (int e = 0; e < 16; ++e) num[i][e] = 0.f;
    const u16* ct = (const u16*)(ws_ + OFF_CTB) + ((size_t)(h * NCH + c) * 128) * 128;
    const float* nsv = NS + (size_t)(h * NCH + c) * 128;
#pragma unroll 4
    for (int ks = 0; ks < 8; ++ks) {
        const int d0 = ks * 16 + hh * 8;
        const bf8 bqv = ld_bf8(QC + ks * 16);
#pragma unroll
        for (int emt = 0; emt < 4; ++emt) {
            const bf8 af = ld_bf8(ct + (size_t)(emt * 32 + q) * 128 + d0);
            num[emt] = mfma32(af, bqv, num[emt]);
        }
        float4 n0 = make_float4(0.f, 0.f, 0.f, 0.f), n1 = n0;
        if (q == 0) { n0 = *(const float4*)(nsv + d0); n1 = *(const float4*)(nsv + d0 + 4); }
        const bf8 an = pack8(n0.x, n0.y, n0.z, n0.w, n1.x, n1.y, n1.z, n1.w);
        num[4] = mfma32(an, bqv, num[4]);
    }
    const float isc = __expf(mprev - cmq);
#pragma unroll
    for (int i = 0; i < 5; ++i)
#pragma unroll
        for (int e = 0; e < 16; ++e) num[i][e] *= isc;
    const int g16 = lane >> 4, i16 = lane & 15, qrow = i16 >> 2, pp = i16 & 3, hp = g16 >> 1;
    const unsigned char* vb = smem + C3_V + h * 64 * ROWB;
    const bf8 ones = pack8(1.f, 1.f, 1.f, 1.f, 1.f, 1.f, 1.f, 1.f), zeros = pack8(0.f, 0.f, 0.f, 0.f, 0.f, 0.f, 0.f, 0.f);
    const bf8 aext = (q == 0) ? ones : zeros;
#pragma unroll
    for (int mt = 0; mt < 2; ++mt)
#pragma unroll
        for (int sp = 0; sp < 2; ++sp) {
            const bf8 bp = pack8(xacc[mt][8 * sp + 0], xacc[mt][8 * sp + 1], xacc[mt][8 * sp + 2], xacc[mt][8 * sp + 3],
                                 xacc[mt][8 * sp + 4], xacc[mt][8 * sp + 5], xacc[mt][8 * sp + 6], xacc[mt][8 * sp + 7]);
            const int rb = mt * 32 + 16 * sp + 4 * hp + qrow;
#pragma unroll
            for (int emt = 0; emt < 4; ++emt) {
                const unsigned char* a0 = vb + rb * ROWB + (32 * emt + 16 * (g16 & 1) + 4 * pp) * 2;
                const bf8 af = tr_pair(a0, a0 + 8 * ROWB);
                num[emt] = mfma32(af, bp, num[emt]);
            }
            num[4] = mfma32(aext, bp, num[4]);
            __builtin_amdgcn_sched_barrier(0);
        }
    const float den = __shfl(num[4][0], q);
    const float mrow = bq_ + cmq;
    const float dn = fmaxf(fabsf(den), __expf(-mrow));
    const float rdn = 1.f / dn;
    const size_t t = (size_t)(tc + lq);
    float s1 = 0.f, s2 = 0.f;
#pragma unroll
    for (int emt = 0; emt < 4; ++emt)
#pragma unroll
        for (int rg = 0; rg < 4; ++rg) {
            const int e0 = emt * 32 + 8 * rg + 4 * hh;
            const uint2 oz = *(const uint2*)(P + t * PLD + C_CO + h * 128 + e0);
            const float v0 = num[emt][4 * rg + 0] * rdn * sigmoidf(bflo(oz.x));
            const float v1 = num[emt][4 * rg + 1] * rdn * sigmoidf(bfhi(oz.x));
            const float v2 = num[emt][4 * rg + 2] * rdn * sigmoidf(bflo(oz.y));
            const float v3 = num[emt][4 * rg + 3] * rdn * sigmoidf(bfhi(oz.y));
            num[emt][4 * rg + 0] = v0; num[emt][4 * rg + 1] = v1; num[emt][4 * rg + 2] = v2; num[emt][4 * rg + 3] = v3;
            s1 += v0 + v1 + v2 + v3; s2 += v0 * v0 + v1 * v1 + v2 * v2 + v3 * v3;
            __builtin_amdgcn_sched_barrier(0);
        }
    s1 += __shfl_xor(s1, 32); s2 += __shfl_xor(s2, 32);
    const float mu = s1 * (1.f / 128.f);
    const float var = fmaxf(s2 * (1.f / 128.f) - mu * mu, 0.f);
    const float rs = rsqrtf(var + 1e-6f);
    const float* cnw = p.c_norm_w + l * 512 + h * 128;
#pragma unroll
    for (int emt = 0; emt < 4; ++emt)
#pragma unroll
        for (int rg = 0; rg < 4; ++rg) {
            const int e0 = emt * 32 + 8 * rg + 4 * hh;
            const uint2 zz = *(const uint2*)(P + t * PLD + C_CZ + h * 128 + e0);
            const float4 nw = *(const float4*)(cnw + e0);
            const float y0 = (num[emt][4 * rg + 0] - mu) * rs * nw.x * siluf(bflo(zz.x));
            const float y1 = (num[emt][4 * rg + 1] - mu) * rs * nw.y * siluf(bfhi(zz.x));
            const float y2 = (num[emt][4 * rg + 2] - mu) * rs * nw.z * siluf(bflo(zz.y));
            const float y3 = (num[emt][4 * rg + 3] - mu) * rs * nw.w * siluf(bfhi(zz.y));
            *(uint2*)(YBR + t * 1536 + 1024 + h * 128 + e0) = make_uint2(pk2(y0, y1), pk2(y2, y3));
            __builtin_amdgcn_sched_barrier(0);
        }
    __syncthreads();
}

__global__ void __launch_bounds__(512) mega(Params p) {
    extern __shared__ __attribute__((aligned(16))) unsigned char smem[];
    cg::grid_group grid = cg::this_grid();
    if (blockIdx.x == 0) { for (int i = threadIdx.x; i < (int)(CTL_BYTES / 4); i += 512) ((u32*)(p.ws + OFF_CTL))[i] = 0; }
    volatile LAS unsigned* xst = (volatile LAS unsigned*)(smem + LDS_BYTES - 32);
    if (threadIdx.x == 0) { xst[0] = 0; xst[1] = 0; }
    phase_p0(p, smem);
    phase_px(p, p.x);
    grid.sync();
    const XcdBarrier xb = xcd_barrier_post((unsigned*)(p.ws + OFF_BAR), xst);
#pragma unroll 1
    for (int l = 0; l < 2; ++l) {
        if (l == 1) { phase_px(p, p.out); xcd_barrier(xb); }
#pragma unroll 1
        for (int b = 0; b < NBATCH; ++b) {
            for (int rep = 0; rep < DUP_G1; ++rep) phase_g1(p, l, b, smem);
            xcd_barrier(xb);
            {
                u32* qhead = (u32*)(p.ws + OFF_CTL) + (l * 2 + b) * 8;
                u32* qslot = (u32*)(smem + LDS_BYTES - 16);
#pragma unroll 1
                for (;;) {
                    __syncthreads();
                    if (threadIdx.x == 0) *qslot = atomicAdd(qhead, 1u);
                    __syncthreads();
                    const int item = (int)*qslot;
                    if (item >= 1024) break;
                    if (item < 512) a_unit(p, 255 - (item >> 1), item & 1, smem);
                    else if (item < 768) { for (int rep = 0; rep < DUP_B; ++rep) b_unit(p, l, item - 512, smem); }
                    else { for (int rep = 0; rep < DUP_C1; ++rep) c1_unit(p, l, item - 768, smem); }
                }
            }
            xcd_barrier(xb);
            {
                u32* qheads = (u32*)(p.ws + OFF_CTL) + (l * 2 + b) * 8 + 1;
                u32* qslot = (u32*)(smem + LDS_BYTES - 16);
#pragma unroll 1
                for (;;) {
                    __syncthreads();
                    if (threadIdx.x == 0) *qslot = atomicAdd(qheads + 2, 1u);
                    __syncthreads();
                    const int item = (int)*qslot;
                    if (item >= 257) break;
                    m2_unit(p, item, smem);
                    asm volatile("s_waitcnt vmcnt(0)" ::: "memory");
                    __syncthreads();
                    if (threadIdx.x == 0) {
                        __builtin_amdgcn_fence(__ATOMIC_RELEASE, "agent");
                        asm volatile("s_waitcnt vmcnt(0)" ::: "memory");
                        __hip_atomic_fetch_add(qheads + 3, 1u, __ATOMIC_RELAXED, __HIP_MEMORY_SCOPE_AGENT);
                    }
                }
                const int g0 = (int)(xb.x & 1u);
                int natt = 0; bool c3_done = false;
#pragma unroll 1
                for (int pass = 0; pass < 2; ++pass) {
                    const int g = g0 ^ pass;
#pragma unroll 1
                    for (;;) {
                        if (!c3_done && (natt >= 2 || pass == 1)) {
                            bool acquired = false;
#pragma unroll 1
                            for (;;) {
                                __syncthreads();
                                if (threadIdx.x == 0) *qslot = atomicAdd(qheads + 4, 1u);
                                __syncthreads();
                                const int citem = (int)*qslot;
                                if (citem >= 256) break;
                                if (!acquired) {
                                    if (threadIdx.x == 0) {
                                        unsigned spins = 0;
                                        while (__hip_atomic_load(qheads + 3, __ATOMIC_RELAXED, __HIP_MEMORY_SCOPE_AGENT) < 257u) { __builtin_amdgcn_s_sleep(2); if (++spins > (1u << 24)) break; }
                                        __builtin_amdgcn_fence(__ATOMIC_ACQUIRE, "agent");
                                        asm volatile("s_waitcnt vmcnt(0)" ::: "memory");
                                    }
                                    __syncthreads();
                                    acquired = true;
                                }
                                for (int rep = 0; rep < DUP_C3; ++rep) c3_unit(p, l, citem, smem);
                            }
                            c3_done = true;
                        }
                        __syncthreads();
                        if (threadIdx.x == 0) *qslot = atomicAdd(qheads + g, 1u);
                        __syncthreads();
                        const int item = (int)*qslot;
                        if (item >= 512) break;
                        att_unit(p, 255 - (item >> 1), item & 1, g, smem);
                        ++natt;
                    }
                }
            }
            xcd_barrier(xb);
            for (int rep = 0; rep < DUP_G2; ++rep) phase_g2(p, l, b, smem);
            xcd_barrier(xb);
            phase_g3(p, l, b, smem);
            xcd_barrier(xb);
        }
    }
    phase_pf(p);
}

extern "C" void kernel_launch(void* const* d_in, const int* in_sizes, int n_in, void* d_out, int out_size, void* d_ws, size_t ws_size, hipStream_t stream) {
    static int grid_blocks = 0;
    if (!grid_blocks) {
        int dev = 0, cus = 0, per_cu = 0;
        hipGetDevice(&dev);
        hipDeviceGetAttribute(&cus, hipDeviceAttributeMultiprocessorCount, dev);
        hipFuncSetAttribute((const void*)mega, hipFuncAttributeMaxDynamicSharedMemorySize, LDS_BYTES);
        hipOccupancyMaxActiveBlocksPerMultiprocessor(&per_cu, mega, 512, LDS_BYTES);
        if (per_cu < 1) { fprintf(stderr, "occupancy query says 0 blocks/CU\n"); per_cu = 1; }
        grid_blocks = cus;
        if (ws_size < WS_NEED) fprintf(stderr, "workspace too small: %zu < %zu\n", ws_size, (size_t)WS_END);
    }
    Params p{};
    p.x = (const float*)d_in[0]; p.norm_g = (const float*)d_in[1]; p.w_in = (const float*)d_in[2]; p.b_in = (const float*)d_in[3];
    p.f_bias = (const float*)d_in[4]; p.conv_w = (const float*)d_in[5]; p.conv_b = (const float*)d_in[6]; p.rel_bias = (const float*)d_in[7];
    p.c_norm_w = (const float*)d_in[8]; p.w_branch = (const float*)d_in[9]; p.w_out = (const float*)d_in[10]; p.final_g = (const float*)d_in[11];
    p.out = (float*)d_out; p.ws = (unsigned char*)d_ws;
    void* args[] = {&p};
    hipError_t e = hipLaunchCooperativeKernel((void*)mega, dim3(grid_blocks), dim3(512), args, LDS_BYTES, stream);
    if (e != hipSuccess) fprintf(stderr, "cooperative launch failed: %s (grid %d)\n", hipGetErrorString(e), grid_blocks);
}
```

```cpp
#include <hip/hip_runtime.h>
#include <hip/hip_cooperative_groups.h>
#include <cstdio>
namespace cg = cooperative_groups;
#ifndef DUP_G1
#define DUP_G1 1
#endif
#ifndef DUP_ASEL
#define DUP_ASEL 1
#endif
#ifndef DUP_AATT
#define DUP_AATT 1
#endif
#ifndef DUP_B
#define DUP_B 1
#endif
#ifndef DUP_C1
#define DUP_C1 1
#endif
#ifndef DUP_C3
#define DUP_C3 1
#endif
#ifndef DUP_G2
#define DUP_G2 1
#endif

typedef __bf16 bf8 __attribute__((ext_vector_type(8)));
typedef float f32x16 __attribute__((ext_vector_type(16)));
typedef float f32x4 __attribute__((ext_vector_type(4)));
typedef short s16x4 __attribute__((ext_vector_type(4)));
typedef unsigned short u16;
typedef unsigned int u32;
typedef unsigned long long u64;

constexpr int SEQ = 16384, NBATCH = 2, T_TOK = 32768, DM = 1024, NCH = 256;
constexpr int INW = 9292;
constexpr int C_AQ = 0, C_AK = 512, C_IQ = 768, C_IK = 1024, C_AZ = 1088, C_BQ = 1600, C_BK = 2112, C_BV = 2624, C_BZ = 3136,
              C_CQ = 3648, C_CK = 4160, C_CV = 4672, C_CO = 5184, C_CZ = 5696, C_SM = 6208, N1 = 6272, PLD = 6208;
constexpr int LDS_BYTES = 160 * 1024;

constexpr size_t al(size_t x) { return (x + 255) & ~(size_t)255; }
constexpr size_t OFF_CS = 0;
constexpr size_t OFF_WT1 = al(OFF_CS + (size_t)SEQ * 8 * 8);
constexpr size_t OFF_WG = al(OFF_WT1 + (size_t)2 * N1 * 1024 * 2);
constexpr size_t OFF_WB = al(OFF_WG + (size_t)2 * 3072 * 1024 * 2);
constexpr size_t OFF_WO = al(OFF_WB + (size_t)2 * 3 * 1024 * 512 * 2);
constexpr size_t OFF_B1 = al(OFF_WO + (size_t)2 * 1024 * 1024 * 2);
constexpr size_t OFF_BG = al(OFF_B1 + (size_t)2 * N1 * 4);
constexpr size_t OFF_XB = al(OFF_BG + (size_t)2 * 3072 * 4);
constexpr size_t OFF_R = al(OFF_XB + (size_t)T_TOK * 1024 * 2);
constexpr size_t OFF_P = al(OFF_R + (size_t)T_TOK * 4);
constexpr size_t OFF_KVA = al(OFF_P + (size_t)SEQ * PLD * 2);
constexpr size_t OFF_IK = al(OFF_KVA + (size_t)SEQ * 256 * 2);
constexpr size_t OFF_SM = al(OFF_IK + (size_t)SEQ * 64 * 2);
constexpr size_t OFF_YBR = al(OFF_SM + (size_t)SEQ * 16 * 4);
constexpr size_t OFF_KVS = al(OFF_YBR + (size_t)SEQ * 1536 * 2);
constexpr size_t OFF_NS = al(OFF_KVS + (size_t)4 * NCH * 128 * 128 * 4);
constexpr size_t OFF_GC = al(OFF_NS + (size_t)4 * NCH * 128 * 4);
constexpr size_t OFF_ML = al(OFF_GC + (size_t)4 * NCH * 4);
constexpr size_t OFF_MP = al(OFF_ML + (size_t)4 * NCH * 4);
constexpr size_t OFF_MG = al(OFF_MP + (size_t)4 * NCH * 4);
constexpr size_t WS_END = al(OFF_MG + (size_t)SEQ * 1024 * 2);
constexpr size_t OFF_CTL = WS_END;
constexpr size_t OFF_BAR = OFF_CTL + 1024;
constexpr size_t CTL_BYTES = 1024 + 3456 * 4;
constexpr size_t OFF_SEL = al(OFF_CTL + CTL_BYTES);
constexpr size_t OFF_CTB = al(OFF_SEL + (size_t)SEQ * 256 * 2);
constexpr size_t WS_NEED = OFF_CTB + (size_t)4 * NCH * 128 * 128 * 2;
static_assert(WS_NEED <= (size_t)512 * 1024 * 1024, "workspace too large");

struct Params {
    const float *x, *norm_g, *w_in, *b_in, *f_bias, *conv_w, *conv_b, *rel_bias, *c_norm_w, *w_branch, *w_out, *final_g;
    float* out; unsigned char* ws;
};

__device__ __forceinline__ int opaque_tid() { int t = threadIdx.x; asm volatile("" : "+v"(t)); return t; }
__device__ __forceinline__ unsigned char* opaque_ptr(unsigned char* p) { unsigned z = 0; asm volatile("" : "+s"(z)); return p + z; }
__device__ __forceinline__ u32 pk2(float a, float b) {
    __bf16 x = (__bf16)a, y = (__bf16)b;
    return (u32)__builtin_bit_cast(u16, x) | ((u32)__builtin_bit_cast(u16, y) << 16);
}
__device__ __forceinline__ u16 f2bf(float a) { __bf16 x = (__bf16)a; return __builtin_bit_cast(u16, x); }
__device__ __forceinline__ float bf2f(u16 v) { return __uint_as_float((u32)v << 16); }
__device__ __forceinline__ float bflo(u32 v) { return __uint_as_float(v << 16); }
__device__ __forceinline__ float bfhi(u32 v) { return __uint_as_float(v & 0xffff0000u); }
__device__ __forceinline__ bf8 ld_bf8(const void* p) { return *(const bf8*)p; }
__device__ __forceinline__ bf8 u4_to_bf8(uint4 u) { return __builtin_bit_cast(bf8, u); }
__device__ __forceinline__ f32x16 mfma32(bf8 a, bf8 b, f32x16 c) { return __builtin_amdgcn_mfma_f32_32x32x16_bf16(a, b, c, 0, 0, 0); }
__device__ __forceinline__ f32x4 mfma16(bf8 a, bf8 b, f32x4 c) { return __builtin_amdgcn_mfma_f32_16x16x32_bf16(a, b, c, 0, 0, 0); }
__device__ __forceinline__ float wave_sum(float v) {
#pragma unroll
    for (int o = 1; o < 64; o <<= 1) v += __shfl_xor(v, o);
    return v;
}
__device__ __forceinline__ float wave_max(float v) {
#pragma unroll
    for (int o = 1; o < 64; o <<= 1) v = fmaxf(v, __shfl_xor(v, o));
    return v;
}
__device__ __forceinline__ float relu_i(float x) { const int b = __float_as_int(x); return __int_as_float(b > 0 ? b : 0); }
__device__ __forceinline__ float sigmoidf(float x) { return 1.f / (1.f + __expf(-x)); }
__device__ __forceinline__ float siluf(float x) { return x / (1.f + __expf(-x)); }
__device__ __forceinline__ float logsigmoidf(float x) { return fminf(x, 0.f) - log1pf(__expf(-fabsf(x))); }
__device__ __forceinline__ s16x4 ds_tr(const void* p) {
    return __builtin_amdgcn_ds_read_tr16_b64_v4i16((s16x4 __attribute__((address_space(3)))*)(p));
}
__device__ __forceinline__ bf8 tr_pair(const unsigned char* p0, const unsigned char* p1) {
    s16x4 lo = ds_tr(p0), hi = ds_tr(p1);
    typedef short s16x8 __attribute__((ext_vector_type(8)));
    s16x8 r = {lo[0], lo[1], lo[2], lo[3], hi[0], hi[1], hi[2], hi[3]};
    return __builtin_bit_cast(bf8, r);
}
__device__ __forceinline__ bf8 pack8(float a, float b, float c, float d, float e, float f, float g, float h) {
    uint4 u; u.x = pk2(a, b); u.y = pk2(c, d); u.z = pk2(e, f); u.w = pk2(g, h);
    return __builtin_bit_cast(bf8, u);
}


#define XB_TMO      128
#define XB_XCNT(j)  (256  + 64 * (j))
#define XB_XSUB(j)  (1280 + 64 * (j))
#define XB_XGEN(j)  (2304 + 64 * (j))
#define XB_TOP      3328
#define XB_TOPGEN   3392
#define XCD_BAR_WORDS 3456
#define XB_SPIN_CAP (1u << 22)
#define LAS __attribute__((address_space(3)))
__device__ __forceinline__ unsigned xb_ld(unsigned* p)              { return __hip_atomic_load(p, __ATOMIC_RELAXED, __HIP_MEMORY_SCOPE_AGENT); }
__device__ __forceinline__ unsigned xb_add(unsigned* p, unsigned v) { return __hip_atomic_fetch_add(p, v, __ATOMIC_RELAXED, __HIP_MEMORY_SCOPE_AGENT); }
__device__ __forceinline__ unsigned xb_xcc_id() { return (unsigned)__builtin_amdgcn_s_getreg((3 << 11) | 20) & 0xFu; }
#define XB_SPIN(cond, bar) do { unsigned _sp = 0; while (cond) { __builtin_amdgcn_s_sleep(1); \
    if ((++_sp & 255u) == 0u) { if (xb_ld(&(bar)[XB_TMO])) break; if (_sp > XB_SPIN_CAP) { atomicAdd(&(bar)[XB_TMO], 1u); break; } } } } while (0)
struct XcdBarrier { unsigned* bar; unsigned x; volatile LAS unsigned* st; };
__device__ __forceinline__ XcdBarrier xcd_barrier_post(unsigned* bar, volatile LAS unsigned* st) {
    XcdBarrier b; b.bar = bar; b.x = xb_xcc_id(); b.st = st;
    if (threadIdx.x == 0) (void)xb_add(&bar[XB_XCNT(b.x)], 1u);
    return b;
}
__device__ __forceinline__ void xcd_barrier_complete(unsigned* bar, unsigned x, unsigned& nloc, unsigned& nx) {
    const unsigned G = gridDim.x * gridDim.y * gridDim.z;
    unsigned sum, cnt, mine, sp = 0u;
    for (;;) {
        sum = 0u; cnt = 0u; mine = 0u;
#pragma unroll
        for (unsigned j = 0; j < 16; ++j) { const unsigned c = xb_ld(&bar[XB_XCNT(j)]); sum += c; cnt += (c > 0u) ? 1u : 0u; mine = (j == x) ? c : mine; }
        if (sum == G) break;
        __builtin_amdgcn_s_sleep(1);
        if ((++sp & 255u) == 0u) { if (xb_ld(&bar[XB_TMO])) break; if (sp > XB_SPIN_CAP) { atomicAdd(&bar[XB_TMO], 1u); break; } }
    }
    nloc = mine > 0u ? mine : 1u; nx = cnt > 0u ? cnt : 1u;
}
__device__ __forceinline__ void xcd_barrier(const XcdBarrier& b) {
    asm volatile("s_waitcnt vmcnt(0)" ::: "memory");
    __syncthreads();
    if (threadIdx.x == 0) {
        unsigned* bar = b.bar;
        __builtin_amdgcn_s_waitcnt(0);
        unsigned nloc = b.st[0], nx = b.st[1];
        if (nloc == 0u) { xcd_barrier_complete(bar, b.x, nloc, nx); b.st[0] = nloc; b.st[1] = nx; }
        const unsigned old = xb_add(&bar[XB_XSUB(b.x)], 1u);
        const unsigned gen = old / nloc;
        if (old + 1u == (gen + 1u) * nloc) {
            __builtin_amdgcn_fence(__ATOMIC_RELEASE, "agent");
            asm volatile("s_waitcnt vmcnt(0)" ::: "memory");
            const unsigned og = xb_add(&bar[XB_TOP], 1u);
            const unsigned tg = og / nx;
            if (og + 1u == (tg + 1u) * nx) xb_add(&bar[XB_TOPGEN], 1u);
            else XB_SPIN(xb_ld(&bar[XB_TOPGEN]) == tg, bar);
            __builtin_amdgcn_fence(__ATOMIC_ACQUIRE, "agent");
            xb_add(&bar[XB_XGEN(b.x)], 1u);
            asm volatile("s_waitcnt vmcnt(0)" ::: "memory");
        } else {
            XB_SPIN(xb_ld(&bar[XB_XGEN(b.x)]) == gen, bar);
            __builtin_amdgcn_fence(__ATOMIC_ACQUIRE, "agent");
            asm volatile("s_waitcnt vmcnt(0)" ::: "memory");
        }
    }
    __syncthreads();
}

__device__ __forceinline__ int colmap1(int n) {
    if (n < 1088) return n;
    if (n < 5184) return n + 4;
    if (n < 6208) return n + 12;
    if (n < 6212) return 1088 + (n - 6208);
    if (n < 6216) return 5188 + (n - 6212);
    if (n < 6220) return 5192 + (n - 6216);
    return -1;
}
__device__ __forceinline__ void tr_item(const float* __restrict__ src, int ld, int kind, const float* __restrict__ gk, u16* __restrict__ dst,
                                        int K, int k0, int n0, float* tile) {
    const int tid = opaque_tid();
    const int nn = tid & 63, kk0 = tid >> 6;
    int sc = n0 + nn;
    if (kind == 0) sc = colmap1(sc); else if (kind == 1) sc = 6220 + sc;
#pragma unroll
    for (int j = 0; j < 8; ++j) {
        const int kk = kk0 + 8 * j; float v = 0.f;
        if (sc >= 0) { v = src[(size_t)(k0 + kk) * ld + sc]; if (gk) v *= gk[k0 + kk]; }
        tile[kk * 65 + nn] = v;
    }
    __syncthreads();
    const int n = tid >> 3, kg = tid & 7;
    float f[8];
#pragma unroll
    for (int j = 0; j < 8; ++j) f[j] = tile[(kg * 8 + j) * 65 + n];
    uint4 o; o.x = pk2(f[0], f[1]); o.y = pk2(f[2], f[3]); o.z = pk2(f[4], f[5]); o.w = pk2(f[6], f[7]);
    *(uint4*)(dst + (size_t)(n0 + n) * K + k0 + kg * 8) = o;
    __syncthreads();
}
__device__ __forceinline__ void sincos_tab(double a, float& s, float& c) {
    const double k = rint(a * 0.63661977236758134308);
    double r = fma(-k, 1.57079632679489655800e+00, a); r = fma(-k, 6.12323399573676603587e-17, r);
    const int qd = (int)((long long)k & 3);
    const double r2 = r * r;
    const double sp = r * (1.0 + r2 * (-1.0 / 6 + r2 * (1.0 / 120 + r2 * (-1.0 / 5040 + r2 * (1.0 / 362880 + r2 * (-1.0 / 39916800 + r2 * (1.0 / 6227020800.0)))))));
    const double cp = 1.0 + r2 * (-0.5 + r2 * (1.0 / 24 + r2 * (-1.0 / 720 + r2 * (1.0 / 40320 + r2 * (-1.0 / 3628800 + r2 * (1.0 / 479001600.0 + r2 * (-1.0 / 87178291200.0)))))));
    float sv, cv;
    if (qd == 0) { sv = (float)sp; cv = (float)cp; } else if (qd == 1) { sv = (float)cp; cv = (float)-sp; }
    else if (qd == 2) { sv = (float)-sp; cv = (float)-cp; } else { sv = (float)-cp; cv = (float)sp; }
    s = sv; c = cv;
}
__device__ __forceinline__ void phase_p0(const Params& p, unsigned char* smem) {
    unsigned char* ws_ = opaque_ptr(p.ws);
    float* tile = (float*)smem;
    u16* WT1 = (u16*)(ws_ + OFF_WT1); u16* WG = (u16*)(ws_ + OFF_WG); u16* WB = (u16*)(ws_ + OFF_WB); u16* WO = (u16*)(ws_ + OFF_WO);
    constexpr int I1 = 98 * 16, I2 = 48 * 16, I3 = 3 * 16 * 8, I4 = 16 * 16, IL = I1 + I2 + I3 + I4;
    for (int it = blockIdx.x; it < 2 * IL; it += gridDim.x) {
        const int l = it / IL; int r = it % IL;
        const float* g = p.norm_g + l * 1024;
        if (r < I1) { tr_item(p.w_in + (size_t)l * 1024 * INW, INW, 0, g, WT1 + (size_t)l * N1 * 1024, 1024, (r & 15) * 64, (r >> 4) * 64, tile); continue; } r -= I1;
        if (r < I2) { tr_item(p.w_in + (size_t)l * 1024 * INW, INW, 1, g, WG + (size_t)l * 3072 * 1024, 1024, (r & 15) * 64, (r >> 4) * 64, tile); continue; } r -= I2;
        if (r < I3) { const int nb = r / 128, rr = r % 128;
            tr_item(p.w_branch + ((size_t)(l * 3 + nb)) * 512 * 1024, 1024, 2, nullptr, WB + ((size_t)(l * 3 + nb)) * 1024 * 512, 512, (rr & 7) * 64, (rr >> 3) * 64, tile); continue; } r -= I3;
        tr_item(p.w_out + (size_t)l * 1024 * 1024, 1024, 2, nullptr, WO + (size_t)l * 1024 * 1024, 1024, (r & 15) * 64, (r >> 4) * 64, tile);
    }
    const int gt = blockIdx.x * 512 + opaque_tid(), ngt = gridDim.x * 512;
    float* B1 = (float*)(ws_ + OFF_B1); float* BG = (float*)(ws_ + OFF_BG);
    for (int i = gt; i < 2 * N1; i += ngt) { const int l = i / N1, n = i % N1; const int sc = colmap1(n);
        float v = sc >= 0 ? p.b_in[l * INW + sc] : 0.f; if (n >= 6216 && n < 6220) v += p.f_bias[l * 4 + (n - 6216)]; B1[i] = v; }
    for (int i = gt; i < 2 * 3072; i += ngt) { const int l = i / 3072, n = i % 3072; BG[i] = p.b_in[l * INW + 6220 + n]; }
    float2* CS = (float2*)(ws_ + OFF_CS);
    for (int i = gt; i < SEQ * 8; i += ngt) {
        const int pos = i >> 3, fi = i & 7;
        const float invf = 1.0f / powf(500000.0f, (float)fi * 2.0f / 16.0f);
        const float ang = (float)pos * invf;
        float s, c; sincos_tab((double)ang, s, c);
        CS[i] = make_float2(c, s);
    }
}
__device__ __forceinline__ void phase_px(const Params& p, const float* xsrc) {
    unsigned char* ws_ = opaque_ptr(p.ws);
    const int tid0 = opaque_tid(), lane = tid0 & 63, wave = tid0 >> 6;
    u16* XB = (u16*)(ws_ + OFF_XB); float* R = (float*)(ws_ + OFF_R);
    for (int row = blockIdx.x * 8 + wave; row < T_TOK; row += gridDim.x * 8) {
        const float4* xr = (const float4*)(xsrc + (size_t)row * DM);
        float4 v[4]; float s = 0.f;
#pragma unroll
        for (int j = 0; j < 4; ++j) { v[j] = xr[lane + 64 * j]; s += v[j].x * v[j].x + v[j].y * v[j].y + v[j].z * v[j].z + v[j].w * v[j].w; }
        s = wave_sum(s);
        if (lane == 0) R[row] = rsqrtf(s * (1.f / DM) + 1e-6f);
        uint2* o = (uint2*)(XB + (size_t)row * DM);
#pragma unroll
        for (int j = 0; j < 4; ++j) o[lane + 64 * j] = make_uint2(pk2(v[j].x, v[j].y), pk2(v[j].z, v[j].w));
    }
}
__device__ __forceinline__ void phase_pf(const Params& p) {
    unsigned char* ws_ = opaque_ptr(p.ws);
    const int tid0 = opaque_tid(), lane = tid0 & 63, wave = tid0 >> 6;
    for (int row = blockIdx.x * 8 + wave; row < T_TOK; row += gridDim.x * 8) {
        float4* xr = (float4*)(p.out + (size_t)row * DM);
        float4 v[4]; float s = 0.f;
#pragma unroll
        for (int j = 0; j < 4; ++j) { v[j] = xr[lane + 64 * j]; s += v[j].x * v[j].x + v[j].y * v[j].y + v[j].z * v[j].z + v[j].w * v[j].w; }
        s = wave_sum(s);
        const float r = rsqrtf(s * (1.f / DM) + 1e-6f);
        const float4* g = (const float4*)p.final_g;
#pragma unroll
        for (int j = 0; j < 4; ++j) { const float4 gg = g[lane + 64 * j]; float4 w; w.x = v[j].x * r * gg.x; w.y = v[j].y * r * gg.y; w.z = v[j].z * r * gg.z; w.w = v[j].w * r * gg.w; xr[lane + 64 * j] = w; }
    }
}

template <int MT>
__device__ __forceinline__ void gemm_compute(f32x16 (&acc)[MT][2], const unsigned char* sA, const unsigned char* sB) {
#pragma unroll
    for (int ks = 0; ks < 4; ++ks) {
        bf8 a[MT], b[2];
#pragma unroll
        for (int mt = 0; mt < MT; ++mt) a[mt] = ld_bf8(sA + mt * 32 * 144 + ks * 32);
#pragma unroll
        for (int nt = 0; nt < 2; ++nt) b[nt] = ld_bf8(sB + nt * 32 * 144 + ks * 32);
#pragma unroll
        for (int mt = 0; mt < MT; ++mt)
#pragma unroll
            for (int nt = 0; nt < 2; ++nt) acc[mt][nt] = mfma32(a[mt], b[nt], acc[mt][nt]);
    }
}
#define GEMM_GLOAD(S, KT) do { const int kk_ = (KT) * 64; \
    S##a0 = *(const uint4*)(ga + kk_); S##a1 = *(const uint4*)(ga + (size_t)64 * lda + kk_); \
    if (MT == 2) { S##a2 = *(const uint4*)(ga + (size_t)128 * lda + kk_); S##a3 = *(const uint4*)(ga + (size_t)192 * lda + kk_); } \
    S##b0 = *(const uint4*)(gb + kk_); S##b1 = *(const uint4*)(gb + (size_t)64 * ldb + kk_); } while (0)
#define GEMM_LSTORE(S, ST) do { unsigned char* pa_ = smem + (ST) * STAGE + lrow * 144 + lch * 16; unsigned char* pb_ = pa_ + BM * 144; \
    *(uint4*)(pa_) = S##a0; *(uint4*)(pa_ + 64 * 144) = S##a1; \
    if (MT == 2) { *(uint4*)(pa_ + 128 * 144) = S##a2; *(uint4*)(pa_ + 192 * 144) = S##a3; } \
    *(uint4*)(pb_) = S##b0; *(uint4*)(pb_ + 64 * 144) = S##b1; } while (0)
#define GEMM_DECL(MT_) \
    constexpr int MT = MT_; constexpr int BM = MT * 128; constexpr int STAGE = (BM + 128) * 144; \
    uint4 r0a0, r0a1, r0a2 = make_uint4(0, 0, 0, 0), r0a3 = r0a2, r0b0, r0b1, r1a0, r1a1, r1a2 = r0a2, r1a3 = r0a2, r1b0, r1b1; \
    const int lrow = tid0 >> 3, lch = tid0 & 7; \
    const int fr = (lane & 31) * 144 + (lane >> 5) * 16; \
    const unsigned char* sA0 = smem + (wm * (MT * 32)) * 144 + fr; \
    const unsigned char* sB0 = smem + BM * 144 + (wn * 64) * 144 + fr; \
    const u16* ga = nullptr; const u16* gb = nullptr; int lda = 0, ldb = 0;
#define GEMM_ISSUE(A_, LDA_, B_, LDB_) do { lda = (LDA_); ldb = (LDB_); ga = (A_) + (size_t)lrow * lda + lch * 8; gb = (B_) + (size_t)lrow * ldb + lch * 8; \
    GEMM_GLOAD(r0, 0); GEMM_GLOAD(r1, 1); } while (0)
#define GEMM_RUN(K_, ACC) do { const int nk = (K_) >> 6; GEMM_LSTORE(r0, 0); __syncthreads(); \
    _Pragma("unroll 1") for (int kt = 0; kt < nk; kt += 2) { \
        GEMM_GLOAD(r0, kt + 2 < nk ? kt + 2 : kt); \
        gemm_compute<MT>(ACC, sA0, sB0); \
        GEMM_LSTORE(r1, 1); __syncthreads(); \
        GEMM_GLOAD(r1, kt + 3 < nk ? kt + 3 : kt + 1); \
        gemm_compute<MT>(ACC, sA0 + STAGE, sB0 + STAGE); \
        GEMM_LSTORE(r0, 0); __syncthreads(); } } while (0)

namespace pg8 {
#define PG8_LAS __attribute__((address_space(3)))
typedef unsigned short bf16_t;
typedef __bf16 mbf8 __attribute__((ext_vector_type(8)));
typedef float f32x4 __attribute__((ext_vector_type(4)));
typedef unsigned u32x4 __attribute__((ext_vector_type(4)));
constexpr int BM = 256, BK = 64, HALF = 128, HTB = HALF * BK * 2, STAGE_BYTES = 8 * HTB, NXCD = 8, WGM = 8;
__host__ __device__ __forceinline__ int lds_byte(int r, int c) { const int st = (r >> 4) * 2 + (c >> 5), rr = r & 15, cc = c & 31, ob = rr * 64 + cc * 2; return st * 1024 + (ob ^ (((ob >> 9) & 1) << 5)); }
__host__ __device__ __forceinline__ void stage_rc(int b, int& R, int& C) { const int st = b / 1024, sb = b % 1024, swz = sb ^ (((sb >> 9) & 1) << 5); R = (st >> 1) * 16 + swz / 64; C = (st & 1) * 32 + (swz % 64) / 2; }
__host__ __device__ __forceinline__ int perm32(int rho) { const int n = rho >> 4, i = rho & 15; return 8 * (i >> 2) + 4 * n + (i & 3); }
struct Unit { int pm, pn, seg; };
struct Gemm { const bf16_t* A; const bf16_t* Bt; int lda, ldb, K; size_t segA, segB; };
struct StaticOrder {
    int nM, nN, nwg, G, c;
    __device__ void init(int M, int N, int G_, int c_) { nM = M / BM; nN = N / BM; nwg = nM * nN; G = G_; c = c_; }
    __device__ bool next(int i, Unit& u) const {
        const long L = (long)i * G + c; if (L >= nwg) return false;
        int wgid = (int)L; { const int q = nwg / NXCD, r = nwg % NXCD, xcd = wgid % NXCD, off = wgid / NXCD; wgid = (xcd < r ? xcd * (q + 1) : r * (q + 1) + (xcd - r) * q) + off; }
        const int nig = WGM * nN, gid = wgid / nig, fm = gid * WGM, gsz = (nM - fm) < WGM ? (nM - fm) : WGM;
        u.pm = fm + ((wgid % nig) % gsz); u.pn = (wgid % nig) / gsz; u.seg = 0; return true;
    }
};
template <class Epi, class Sched>
__device__ __forceinline__ void gemm_phase(PG8_LAS unsigned char* lds, const Gemm g, const Sched& S, const Epi& E) {
    const int tid = opaque_tid(), wid = __builtin_amdgcn_readfirstlane(tid >> 6), lane = tid & 63, wr = wid >> 2, wc = wid & 3, fr = lane & 15, fq = lane >> 4;
    const int nt = g.K / BK;
    unsigned voffA[2], voffB[2];
#pragma unroll
    for (int i = 0; i < 2; ++i) { int R, C; stage_rc(tid * 16 + i * 8192, R, C); const int Rb = Epi::PERM ? ((R & ~31) + perm32(R & 31)) : R;
        voffA[i] = (unsigned)(R * g.lda + C) * 2u; voffB[i] = (unsigned)(Rb * g.ldb + C) * 2u; }
    const size_t kstep = (size_t)(BK * 2);
    const size_t hstepA = (size_t)HALF * g.lda * 2, hstepB = (size_t)HALF * g.ldb * 2;
    const size_t tstepA = 2 * hstepA, tstepB = 2 * hstepB;
    const unsigned ldsw = (unsigned)wid * 1024u;
    const int aoff = lds_byte(wr * 64 + fr, fq * 8), boff = lds_byte(wc * 32 + fr, fq * 8);
#define PG8_SA(b, h) (((b) * 2 + (h)) * HTB)
#define PG8_SB(b, h) ((4 + (b) * 2 + (h)) * HTB)
#define PG8_STAGE(bufoff, gbase, voff) do { _Pragma("unroll") for (int _i = 0; _i < 2; ++_i) \
        __builtin_amdgcn_global_load_lds((const unsigned*)((const char*)(gbase) + (voff)[_i]), (PG8_LAS unsigned*)(lds + (bufoff) + ldsw + _i * 8192), 16, 0, 0); } while (0)
#define PG8_LDA(dst, b, h) do { _Pragma("unroll") for (int m = 0; m < 4; ++m) _Pragma("unroll") for (int k = 0; k < 2; ++k) dst[m][k] = *(const PG8_LAS mbf8*)(lds + PG8_SA(b, h) + aoff + m * 2048 + k * 1024); } while (0)
#define PG8_LDB(dst, b, h) do { _Pragma("unroll") for (int n = 0; n < 2; ++n) _Pragma("unroll") for (int k = 0; k < 2; ++k) dst[n][k] = *(const PG8_LAS mbf8*)(lds + PG8_SB(b, h) + boff + n * 2048 + k * 1024); } while (0)
#define PG8_MMA(ai, bj, At, Bt) do { __builtin_amdgcn_s_setprio(1); _Pragma("unroll") for (int m = 0; m < 4; ++m) _Pragma("unroll") for (int n = 0; n < 2; ++n) _Pragma("unroll") for (int k = 0; k < 2; ++k) \
        acc[ai][bj][m][n] = __builtin_amdgcn_mfma_f32_16x16x32_bf16(Bt[n][k], At[m][k], acc[ai][bj][m][n], 0, 0, 0); __builtin_amdgcn_s_setprio(0); } while (0)
#define PG8_WAIT_V(n) asm volatile("s_waitcnt vmcnt(" #n ")" ::: "memory")
#define PG8_WAIT_L(n) asm volatile("s_waitcnt lgkmcnt(" #n ")" ::: "memory")
#define PG8_BAR __builtin_amdgcn_s_barrier()
#define PG8_SCHED __builtin_amdgcn_sched_barrier(0)
    Unit cur, nxt; int ui = 0;
    if (!S.next(0, cur)) return;
    f32x4 acc[2][2][4][2];
#pragma unroll
    for (int a = 0; a < 2; ++a)
#pragma unroll
        for (int b = 0; b < 2; ++b)
#pragma unroll
            for (int m = 0; m < 4; ++m)
#pragma unroll
                for (int n = 0; n < 2; ++n) acc[a][b][m][n] = (f32x4){0.f, 0.f, 0.f, 0.f};
    mbf8 At[4][2], B0[2][2], B1[2][2];
    const char* cA = (const char*)g.A + (size_t)cur.seg * g.segA + (size_t)cur.pm * tstepA; const char* cB = (const char*)g.Bt + (size_t)cur.seg * g.segB + (size_t)cur.pn * tstepB;
    PG8_STAGE(PG8_SB(0, 0), cB, voffB); PG8_STAGE(PG8_SA(0, 0), cA, voffA); PG8_STAGE(PG8_SB(0, 1), cB + hstepB, voffB); PG8_STAGE(PG8_SA(0, 1), cA + hstepA, voffA);
    if (wr == 1) PG8_BAR;
    PG8_WAIT_V(4); PG8_BAR;
    PG8_STAGE(PG8_SB(1, 0), cB + kstep, voffB); PG8_STAGE(PG8_SA(1, 0), cA + kstep, voffA); PG8_STAGE(PG8_SB(1, 1), cB + hstepB + kstep, voffB);
    PG8_WAIT_V(6); PG8_BAR;
    for (;;) {
        const bool has_next = S.next(ui + 1, nxt);
        const char* nA = has_next ? (const char*)g.A + (size_t)nxt.seg * g.segA + (size_t)nxt.pm * tstepA : cA; const char* nB = has_next ? (const char*)g.Bt + (size_t)nxt.seg * g.segB + (size_t)nxt.pn * tstepB : cB;
        for (int t = 0; t < nt; t += 2) {
            const bool last = (t == nt - 2);
            const char* a1 = cA + (size_t)(t + 1) * kstep;
            const char* a2 = last ? nA : cA + (size_t)(t + 2) * kstep; const char* b2 = last ? nB : cB + (size_t)(t + 2) * kstep;
            const char* a3 = a2 + kstep; const char* b3 = b2 + kstep;
            PG8_LDB(B0, 0, 0); PG8_SCHED; PG8_LDA(At, 0, 0); PG8_STAGE(PG8_SA(1, 1), a1 + hstepA, voffA);
            PG8_WAIT_L(8); PG8_BAR; PG8_WAIT_L(0); PG8_MMA(0, 0, At, B0); PG8_BAR; PG8_SCHED;
            PG8_LDB(B1, 0, 1); PG8_STAGE(PG8_SB(0, 0), b2, voffB);
            PG8_BAR; PG8_WAIT_L(0); PG8_MMA(0, 1, At, B1); PG8_BAR;
            PG8_LDA(At, 0, 1); PG8_STAGE(PG8_SA(0, 0), a2, voffA);
            PG8_BAR; PG8_WAIT_L(0); PG8_MMA(1, 0, At, B0); PG8_BAR; PG8_SCHED;
            PG8_STAGE(PG8_SB(0, 1), b2 + hstepB, voffB);
            PG8_WAIT_V(6); PG8_BAR; PG8_MMA(1, 1, At, B1); PG8_BAR;
            PG8_LDB(B0, 1, 0); PG8_SCHED; PG8_LDA(At, 1, 0); PG8_STAGE(PG8_SA(0, 1), a2 + hstepA, voffA);
            PG8_WAIT_L(8); PG8_BAR; PG8_WAIT_L(0); PG8_MMA(0, 0, At, B0); PG8_BAR; PG8_SCHED;
            PG8_LDB(B1, 1, 1); PG8_STAGE(PG8_SB(1, 0), b3, voffB);
            PG8_BAR; PG8_WAIT_L(0); PG8_MMA(0, 1, At, B1); PG8_BAR;
            PG8_LDA(At, 1, 1); PG8_STAGE(PG8_SA(1, 0), a3, voffA);
            PG8_BAR; PG8_WAIT_L(0); PG8_MMA(1, 0, At, B0); PG8_BAR; PG8_SCHED;
            PG8_STAGE(PG8_SB(1, 1), b3 + hstepB, voffB);
            PG8_WAIT_V(6); PG8_BAR; PG8_MMA(1, 1, At, B1); PG8_BAR;
        }
        E(acc, cur, wr, wc, fr, fq);
        if (!has_next) break;
#pragma unroll
        for (int a = 0; a < 2; ++a)
#pragma unroll
            for (int b = 0; b < 2; ++b)
#pragma unroll
                for (int m = 0; m < 4; ++m)
#pragma unroll
                    for (int n = 0; n < 2; ++n) acc[a][b][m][n] = (f32x4){0.f, 0.f, 0.f, 0.f};
        cur = nxt; cA = nA; cB = nB; ++ui;
    }
    PG8_WAIT_V(0);
    if (wr == 0) PG8_BAR;
    PG8_BAR;
#undef PG8_SA
#undef PG8_SB
#undef PG8_STAGE
#undef PG8_LDA
#undef PG8_LDB
#undef PG8_MMA
#undef PG8_WAIT_V
#undef PG8_WAIT_L
#undef PG8_BAR
#undef PG8_SCHED
}
struct EpiResid {
    static constexpr bool PERM = false;
    const float* xc; float* xo;
    __device__ __forceinline__ void operator()(const f32x4 (&acc)[2][2][4][2], const Unit& u, int wr, int wc, int fr, int fq) const {
        const int row0 = u.pm * BM + wr * 64 + fr, col0 = u.pn * BM + wc * 32 + 4 * fq;
#pragma unroll
        for (int ai = 0; ai < 2; ++ai)
#pragma unroll
            for (int m = 0; m < 4; ++m) {
                const size_t ro = (size_t)(row0 + ai * HALF + m * 16) * 1024 + col0;
#pragma unroll
                for (int bj = 0; bj < 2; ++bj)
#pragma unroll
                    for (int n = 0; n < 2; ++n) { const f32x4 xv = *(const f32x4*)(xc + ro + bj * HALF + n * 16); *(f32x4*)(xo + ro + bj * HALF + n * 16) = xv + acc[ai][bj][m][n]; }
            }
    }
};
struct EpiG1 {
    static constexpr bool PERM = true;
    const float* R; const float* B1; const float2* CS; unsigned short* P; unsigned short* KVA; unsigned short* IK;
    __device__ __forceinline__ void operator()(const f32x4 (&acc)[2][2][4][2], const Unit& u, int wr, int wc, int fr, int fq) const {
        const int row0 = u.pm * BM + wr * 64 + fr;
#pragma unroll
        for (int bj = 0; bj < 2; ++bj) {
            const int cg = u.pn * BM + bj * HALF + wc * 32;
            const int col = cg + 8 * fq;
            const int c64 = cg & ~63;
            const bool rope = ((cg & 63) == 0) && (c64 < 640 || (c64 >= 768 && c64 < 1088));
            const bool kv8 = (c64 >= 512 && c64 < 768);
            unsigned short* dst; int pitch;
            if (c64 == 1024) { dst = IK + (col - 1024); pitch = 64; }
            else { dst = P + col; pitch = 6208; }
            const f32x4 b0 = *(const f32x4*)(B1 + col), b1 = *(const f32x4*)(B1 + col + 4);
#pragma unroll
            for (int ai = 0; ai < 2; ++ai)
#pragma unroll
                for (int m = 0; m < 4; ++m) {
                    const int row = row0 + ai * HALF + m * 16;
                    const float rs = R[row];
                    f32x4 v0 = acc[ai][bj][m][0] * rs + b0, v1 = acc[ai][bj][m][1] * rs + b1;
                    if (rope) {
                        f32x4 p0, p1;
#pragma unroll
                        for (int e = 0; e < 4; ++e) { p0[e] = __shfl_xor(v0[e], 16); p1[e] = __shfl_xor(v1[e], 16); }
                        if (fq < 2) {
                            const f32x4* cs = (const f32x4*)(CS + (size_t)row * 8);
                            const f32x4 c01 = cs[0], c23 = cs[1], c45 = cs[2], c67 = cs[3];
                            const float sg = fq == 0 ? -1.f : 1.f;
                            v0[0] = v0[0] * c01[0] + sg * p0[0] * c01[1]; v0[1] = v0[1] * c01[2] + sg * p0[1] * c01[3];
                            v0[2] = v0[2] * c23[0] + sg * p0[2] * c23[1]; v0[3] = v0[3] * c23[2] + sg * p0[3] * c23[3];
                            v1[0] = v1[0] * c45[0] + sg * p1[0] * c45[1]; v1[1] = v1[1] * c45[2] + sg * p1[1] * c45[3];
                            v1[2] = v1[2] * c67[0] + sg * p1[2] * c67[1]; v1[3] = v1[3] * c67[2] + sg * p1[3] * c67[3];
                        }
                    }
                    if (kv8) {
                        int w0 = __builtin_amdgcn_cvt_pk_fp8_f32(v0[0], v0[1], 0, false); w0 = __builtin_amdgcn_cvt_pk_fp8_f32(v0[2], v0[3], w0, true);
                        int w1 = __builtin_amdgcn_cvt_pk_fp8_f32(v1[0], v1[1], 0, false); w1 = __builtin_amdgcn_cvt_pk_fp8_f32(v1[2], v1[3], w1, true);
                        *(uint2*)((unsigned char*)KVA + (size_t)row * 256 + (col - 512)) = make_uint2((unsigned)w0, (unsigned)w1);
                    } else {
                        u32x4 w; w.x = pk2(v0[0], v0[1]); w.y = pk2(v0[2], v0[3]); w.z = pk2(v1[0], v1[1]); w.w = pk2(v1[2], v1[3]);
                        *(u32x4*)(dst + (size_t)row * pitch) = w;
                    }
                }
        }
    }
};
struct PairOrder {
    int G, c, gatecols;
    __device__ bool next(int i, Unit& u) const {
        const int jj = c + (i / 3) * G, n = i % 3;
        if (jj >= 256) return false;
        const int q = jj & 7, k = jj >> 3;
        const int pmv = q * 8 + (k >> 2), pnv = k & 3;
        u.pm = pmv; u.pn = gatecols ? n * 4 + pnv : pnv; u.seg = gatecols ? 0 : n; return true;
    }
};
struct EpiGate {
    static constexpr bool PERM = true;
    const float* R; const float* BG; unsigned short* GT;
    __device__ __forceinline__ void operator()(const f32x4 (&acc)[2][2][4][2], const Unit& u, int wr, int wc, int fr, int fq) const {
        const int row0 = u.pm * BM + wr * 64 + fr;
#pragma unroll
        for (int bj = 0; bj < 2; ++bj) {
            const int col = u.pn * BM + bj * HALF + wc * 32 + 8 * fq;
            const f32x4 b0 = *(const f32x4*)(BG + col), b1 = *(const f32x4*)(BG + col + 4);
#pragma unroll
            for (int ai = 0; ai < 2; ++ai)
#pragma unroll
                for (int m = 0; m < 4; ++m) {
                    const int row = row0 + ai * HALF + m * 16;
                    const float rs = R[row];
                    const f32x4 v0 = acc[ai][bj][m][0] * rs + b0, v1 = acc[ai][bj][m][1] * rs + b1;
                    u32x4 w; w.x = pk2(sigmoidf(v0[0]), sigmoidf(v0[1])); w.y = pk2(sigmoidf(v0[2]), sigmoidf(v0[3]));
                    w.z = pk2(sigmoidf(v1[0]), sigmoidf(v1[1])); w.w = pk2(sigmoidf(v1[2]), sigmoidf(v1[3]));
                    *(u32x4*)(GT + (size_t)row * 3072 + col) = w;
                }
        }
    }
};
struct EpiMerge {
    static constexpr bool PERM = true;
    const unsigned short* GT; unsigned short* MG;
    __device__ __forceinline__ void operator()(const f32x4 (&acc)[2][2][4][2], const Unit& u, int wr, int wc, int fr, int fq) const {
        const int row0 = u.pm * BM + wr * 64 + fr;
#pragma unroll
        for (int bj = 0; bj < 2; ++bj) {
            const int col = u.pn * BM + bj * HALF + wc * 32 + 8 * fq;
#pragma unroll
            for (int ai = 0; ai < 2; ++ai)
#pragma unroll
                for (int m = 0; m < 4; ++m) {
                    const int row = row0 + ai * HALF + m * 16;
                    const u32x4 gq = *(const u32x4*)(GT + (size_t)row * 3072 + u.seg * 1024 + col);
                    u32x4 pq = {0u, 0u, 0u, 0u};
                    if (u.seg > 0) pq = *(const u32x4*)(MG + (size_t)row * 1024 + col);
                    const f32x4 a0 = acc[ai][bj][m][0], a1 = acc[ai][bj][m][1];
                    u32x4 w;
                    w.x = pk2(bflo(pq.x) + bflo(gq.x) * a0[0], bfhi(pq.x) + bfhi(gq.x) * a0[1]);
                    w.y = pk2(bflo(pq.y) + bflo(gq.y) * a0[2], bfhi(pq.y) + bfhi(gq.y) * a0[3]);
                    w.z = pk2(bflo(pq.z) + bflo(gq.z) * a1[0], bfhi(pq.z) + bfhi(gq.z) * a1[1]);
                    w.w = pk2(bflo(pq.w) + bflo(gq.w) * a1[2], bfhi(pq.w) + bfhi(gq.w) * a1[3]);
                    *(u32x4*)(MG + (size_t)row * 1024 + col) = w;
                }
        }
    }
};
}

__device__ __forceinline__ void phase_g1(const Params& p, int l, int b, unsigned char* smem) {
    unsigned char* ws_ = opaque_ptr(p.ws);
    const int tid0 = opaque_tid(), lane = tid0 & 63, wave = tid0 >> 6, wm = wave >> 1, wn = wave & 1;
    const u16* XB = (const u16*)(ws_ + OFF_XB) + (size_t)b * SEQ * 1024;
    const u16* W = (const u16*)(ws_ + OFF_WT1) + (size_t)l * N1 * 1024;
    const float* R = (const float*)(ws_ + OFF_R) + b * SEQ;
    const float* B1 = (const float*)(ws_ + OFF_B1) + l * N1;
    const float2* CS = (const float2*)(ws_ + OFF_CS);
    u16* P = (u16*)(ws_ + OFF_P); u16* KVA = (u16*)(ws_ + OFF_KVA); u16* IK = (u16*)(ws_ + OFF_IK); float* SM = (float*)(ws_ + OFF_SM);
    {
        pg8::Gemm g; g.A = XB; g.Bt = W; g.lda = 1024; g.ldb = 1024; g.K = 1024; g.segA = 0; g.segB = 0;
        pg8::StaticOrder S; S.init(SEQ, 6144, (int)gridDim.x, (int)blockIdx.x);
        pg8::EpiG1 E; E.R = R; E.B1 = B1; E.CS = CS; E.P = P; E.KVA = KVA; E.IK = IK;
        pg8::gemm_phase((PG8_LAS unsigned char*)smem, g, S, E);
    }
    GEMM_DECL(2)
    if ((int)blockIdx.x < 64) GEMM_ISSUE(XB + (size_t)blockIdx.x * 256 * 1024, 1024, W + (size_t)48 * 128 * 1024, 1024);
    for (int tile = blockIdx.x; tile < 64; tile += gridDim.x) {
        const int tm = tile, tn = 48;
        f32x16 acc[2][2];
#pragma unroll
        for (int i = 0; i < 2; ++i)
#pragma unroll
            for (int j = 0; j < 2; ++j)
#pragma unroll
                for (int e = 0; e < 16; ++e) acc[i][j][e] = 0.f;
        GEMM_RUN(1024, acc);
        { const int nx = tile + gridDim.x; if (nx < 64) GEMM_ISSUE(XB + (size_t)nx * 256 * 1024, 1024, W + (size_t)48 * 128 * 1024, 1024); }
        unsigned char* wreg = smem + wave * (64 * 144);
        const int nb64 = tn * 128 + wn * 64;
#pragma unroll
        for (int nt = 0; nt < 2; ++nt) {
            const int nbase = nb64 + nt * 32;
            const int n = nbase + (lane & 31);
            const float bias = B1[n];
            const bool rope = ((nbase & 63) == 0) && (nbase < 640 || (nbase >= 768 && nbase < 1088));
#pragma unroll
            for (int mt = 0; mt < 2; ++mt) {
#pragma unroll
                for (int reg = 0; reg < 16; ++reg) {
                    const int rl = mt * 32 + (reg & 3) + 8 * (reg >> 2) + 4 * (lane >> 5);
                    const int row = tm * 256 + wm * 64 + rl;
                    float v = acc[mt][nt][reg] * R[row] + bias;
                    if (rope) {
                        const float pv = __shfl_xor(v, 8);
                        if ((lane & 31) < 16) {
                            const float2 cs = CS[row * 8 + (lane & 7)];
                            v = ((lane & 31) < 8) ? (v * cs.x - pv * cs.y) : (v * cs.x + pv * cs.y);
                        }
                    }
                    if (nbase < 6208) *(u16*)(wreg + rl * 144 + (nt * 32 + (lane & 31)) * 2) = f2bf(v);
                    else if (n < 6220) SM[(size_t)row * 16 + (n - 6208)] = v;
                }
                __builtin_amdgcn_sched_barrier(0);
            }
        }
        __builtin_amdgcn_fence(__ATOMIC_RELEASE, "workgroup");
        __builtin_amdgcn_wave_barrier();
        __builtin_amdgcn_fence(__ATOMIC_ACQUIRE, "workgroup");
        if (nb64 < 6208) {
            u16* dst; int pitch;
            if (nb64 >= 512 && nb64 < 768) { dst = KVA + (nb64 - 512); pitch = 256; }
            else if (nb64 == 1024) { dst = IK; pitch = 64; }
            else { dst = P + nb64; pitch = PLD; }
            const int ch = lane & 7;
#pragma unroll
            for (int i = 0; i < 8; ++i) {
                const int rl = (lane >> 3) + 8 * i;
                const uint4 d = *(const uint4*)(wreg + rl * 144 + ch * 16);
                *(uint4*)(dst + (size_t)(tm * 256 + wm * 64 + rl) * pitch + ch * 8) = d;
            }
        }
        __syncthreads();
    }
}
__device__ __forceinline__ void phase_g2(const Params& p, int l, int b, unsigned char* smem) {
    unsigned char* ws_ = opaque_ptr(p.ws);
    u16* GT = (u16*)(ws_ + OFF_P);
    {
        pg8::Gemm g; g.A = (const u16*)(ws_ + OFF_XB) + (size_t)b * SEQ * 1024; g.Bt = (const u16*)(ws_ + OFF_WG) + (size_t)l * 3072 * 1024;
        g.lda = 1024; g.ldb = 1024; g.K = 1024; g.segA = 0; g.segB = 0;
        pg8::PairOrder S; S.G = (int)gridDim.x; S.c = (int)blockIdx.x; S.gatecols = 1;
        pg8::EpiGate E; E.R = (const float*)(ws_ + OFF_R) + b * SEQ; E.BG = (const float*)(ws_ + OFF_BG) + l * 3072; E.GT = GT;
        pg8::gemm_phase((PG8_LAS unsigned char*)smem, g, S, E);
    }
    {
        pg8::Gemm g; g.A = (const u16*)(ws_ + OFF_YBR); g.Bt = (const u16*)(ws_ + OFF_WB) + (size_t)l * 3 * 1024 * 512;
        g.lda = 1536; g.ldb = 512; g.K = 512; g.segA = 512 * 2; g.segB = (size_t)1024 * 512 * 2;
        pg8::PairOrder S; S.G = (int)gridDim.x; S.c = (int)blockIdx.x; S.gatecols = 0;
        pg8::EpiMerge E; E.GT = GT; E.MG = (u16*)(ws_ + OFF_MG);
        pg8::gemm_phase((PG8_LAS unsigned char*)smem, g, S, E);
    }
}

__device__ __forceinline__ void phase_g3(const Params& p, int l, int b, unsigned char* smem) {
    unsigned char* ws_ = opaque_ptr(p.ws);
    pg8::Gemm g; g.A = (const u16*)(ws_ + OFF_MG); g.Bt = (const u16*)(ws_ + OFF_WO) + (size_t)l * 1024 * 1024; g.lda = 1024; g.ldb = 1024; g.K = 1024; g.segA = 0; g.segB = 0;
    pg8::StaticOrder S; S.init(SEQ, 1024, (int)gridDim.x, (int)blockIdx.x);
    pg8::EpiResid E; E.xc = (l == 0 ? p.x : p.out) + (size_t)b * SEQ * 1024; E.xo = p.out + (size_t)b * SEQ * 1024;
    pg8::gemm_phase((PG8_LAS unsigned char*)smem, g, S, E);
}

constexpr int HST = 257;
constexpr int CAP = 256;
constexpr int A_HIST = 0, A_HISTF = 33280, A_HIST2 = 66560, A_CKEY = 0, A_CIDX = 32768, A_PL = 0, A_SEL = 99840, A_ST = A_SEL + 16384, A_FLAG = A_ST + 2048, A_BQ = A_FLAG + 1024;
static_assert(32 * HST * 4 <= A_HISTF && A_HIST2 + 32 * HST * 4 <= A_SEL && 8 * 8192 <= A_SEL && A_BQ + 8192 <= LDS_BYTES - 64, "a lds");
__device__ __forceinline__ void a_unit(const Params& p, int c, int hf, unsigned char* smem) {
    unsigned char* ws_ = opaque_ptr(p.ws);
    const int tid = opaque_tid(), lane = tid & 63, wave = tid >> 6;
    const int q = lane & 31, hh = lane >> 5;
    const u16* P = (const u16*)(ws_ + OFF_P); const u16* KVA = (const u16*)(ws_ + OFF_KVA); const u16* IK = (const u16*)(ws_ + OFF_IK);
    const float* SM = (const float*)(ws_ + OFF_SM); u16* YBR = (u16*)(ws_ + OFF_YBR);
    u32* hist = (u32*)(smem + A_HIST); u16* sel = (u16*)(smem + A_SEL); u32* ckey = (u32*)(smem + A_CKEY); u32* cidx = (u32*)(smem + A_CIDX);
    u32* st = (u32*)(smem + A_ST); u32* flag = (u32*)(smem + A_FLAG);
    const int t0 = c * 64 + hf * 32;
    const int nadm = 64 * (c + 1);
    for (int rep_sel = 0; rep_sel < DUP_ASEL; ++rep_sel) {
    __syncthreads();
    if (c < 4) {
        for (int i = tid; i < 32 * 256; i += 512) { const int s = i & 255; sel[i] = (u16)(s < nadm ? s : 0); }
    } else {
        const size_t tq = (size_t)(t0 + q);
        bf8 bq[4][4];
        float w[4];
        float ssq = 0.f;
#pragma unroll
        for (int h = 0; h < 4; ++h) {
            w[h] = SM[tq * 16 + h] * 0.0625f;
            float n2 = 0.f;
#pragma unroll
            for (int s = 0; s < 4; ++s) {
                const uint4 raw = *(const uint4*)(P + tq * PLD + C_IQ + h * 64 + s * 16 + hh * 8);
                bq[h][s] = u4_to_bf8(raw);
                n2 += bflo(raw.x) * bflo(raw.x) + bfhi(raw.x) * bfhi(raw.x) + bflo(raw.y) * bflo(raw.y) + bfhi(raw.y) * bfhi(raw.y)
                    + bflo(raw.z) * bflo(raw.z) + bfhi(raw.z) * bfhi(raw.z) + bflo(raw.w) * bflo(raw.w) + bfhi(raw.w) * bfhi(raw.w);
            }
            n2 += __shfl_xor(n2, 32);
            ssq += w[h] * w[h] * n2;
        }
        unsigned char* bql = smem + A_BQ + lane * 16;
        if (wave == 0) {
#pragma unroll
            for (int s = 0; s < 4; ++s) { *(bf8*)(bql + s * 1024) = bq[2][s]; *(bf8*)(bql + (4 + s) * 1024) = bq[3][s]; }
        }
        const float sdev = sqrtf(ssq);
        const float rsd = (sdev > 1e-30f) ? 1.f / sdev : 0.f;
        const float bS1 = 1024.f * rsd, bS2 = 256.f * rsd, bS3 = 64.f * rsd, bS4 = 16.f * rsd;
        const int nkt = 2 * (c + 1);
        if (tid < 32) { st[0 * 32 + tid] = 0; st[1 * 32 + tid] = 0; st[2 * 32 + tid] = 256; st[3 * 32 + tid] = 0; st[4 * 32 + tid] = 0; st[5 * 32 + tid] = 0; st[6 * 32 + tid] = 0; st[7 * 32 + tid] = 0; }
        auto load_tile = [&](int kt, bf8 (&a)[4]) {
            const u16* kr = IK + (size_t)(kt * 32 + q) * 64 + hh * 8;
#pragma unroll
            for (int s = 0; s < 4; ++s) a[s] = ld_bf8(kr + s * 16);
        };
        auto score_tile = [&](const bf8 (&a)[4], f32x16& sc) {
            f32x16 acc0, acc1;
#pragma unroll
            for (int e = 0; e < 16; ++e) { acc0[e] = 0.f; acc1[e] = 0.f; }
#pragma unroll
            for (int s = 0; s < 4; ++s) acc0 = mfma32(a[s], bq[0][s], acc0);
#pragma unroll
            for (int s = 0; s < 4; ++s) acc1 = mfma32(a[s], bq[1][s], acc1);
            __builtin_amdgcn_sched_barrier(0);
#pragma unroll
            for (int reg = 0; reg < 16; ++reg) sc[reg] = relu_i(acc0[reg]) * w[0];
#pragma unroll
            for (int e = 0; e < 16; ++e) acc0[e] = 0.f;
            {
                bf8 b2[4];
#pragma unroll
                for (int s = 0; s < 4; ++s) b2[s] = ld_bf8(bql + s * 1024);
#pragma unroll
                for (int s = 0; s < 4; ++s) acc0 = mfma32(a[s], b2[s], acc0);
            }
            __builtin_amdgcn_sched_barrier(0);
#pragma unroll
            for (int reg = 0; reg < 16; ++reg) sc[reg] = fmaf(relu_i(acc1[reg]), w[1], sc[reg]);
#pragma unroll
            for (int e = 0; e < 16; ++e) acc1[e] = 0.f;
            {
                bf8 b3[4];
#pragma unroll
                for (int s = 0; s < 4; ++s) b3[s] = ld_bf8(bql + (4 + s) * 1024);
#pragma unroll
                for (int s = 0; s < 4; ++s) acc1 = mfma32(a[s], b3[s], acc1);
            }
            __builtin_amdgcn_sched_barrier(0);
#pragma unroll
            for (int reg = 0; reg < 16; ++reg) sc[reg] = fmaf(relu_i(acc0[reg]), w[2], sc[reg]);
#pragma unroll
            for (int reg = 0; reg < 16; ++reg) sc[reg] = fmaf(relu_i(acc1[reg]), w[3], sc[reg]) + 0.0f;
        };
        auto bin_mag = [&](float v) -> float {
            const float a = fabsf(v);
            return fminf(fminf(fminf(a * bS1, fmaf(a, bS2, 18.f)), fminf(fmaf(a, bS3, 40.5f), fmaf(a, bS4, 64.125f))), 126.f);
        };
        auto bin_of = [&](float v) -> u32 {
            const u32 m = (u32)bin_mag(v);
            const int sg = __float_as_int(v) >> 31;
            return (u32)(128 + (int)(m ^ (u32)sg));
        };
        auto sub_of = [&](float v) -> u32 {
            const float a = fabsf(v);
            const float s = fminf(fminf(a * bS1, fmaf(a, bS2, 18.f)), fminf(fmaf(a, bS3, 40.5f), fmaf(a, bS4, 64.125f)));
            const float m = floorf(fminf(s, 126.f));
            int sb = (int)fminf((s - m) * 256.f, 255.f);
            return v > 0.f ? (u32)sb : (v < 0.f ? (u32)(255 - sb) : 0u);
        };
        u32* hist2 = (u32*)(smem + A_HIST2);
        int level = 0;
#pragma unroll 1
        for (;; ++level) {
            for (int i = tid; i < 32 * HST; i += 512) { hist[i] = 0; if (level == 0) hist2[i] = 0; }
            __syncthreads();
            const int sh = (level == 7) ? 0 : 54 - 8 * level;
            const int bits = (level == 7) ? 6 : 8;
            if (level == 0) {
              {
                bf8 an[4]; load_tile(wave < nkt ? wave : 0, an);
#pragma unroll 1
                for (int kt = wave; kt < nkt; kt += 8) {
                    bf8 ac[4];
#pragma unroll
                    for (int s = 0; s < 4; ++s) ac[s] = an[s];
                    load_tile(kt + 8 < nkt ? kt + 8 : kt, an);
                    f32x16 sc; score_tile(ac, sc);
                    u32 zc = 0;
#pragma unroll
                    for (int reg = 0; reg < 16; ++reg) {
                        atomicAdd(&hist[q * HST + bin_of(sc[reg])], 1u);
                        zc += (sc[reg] == 0.f) ? 1u : 0u;
                    }
                    if (zc) atomicAdd(&hist2[q * HST + (255u - (u32)(kt >> 1))], zc);
                }
              }
            } else {
                const u64 pref = ((u64)st[1 * 32 + q] << 32) | st[0 * 32 + q];
                const bool qdone = st[3 * 32 + q] != 0;
                const int sh_hi = sh + bits;
                const u32 dmask = (level == 7) ? 63u : 255u;
                bf8 an[4]; load_tile(wave < nkt ? wave : 0, an);
#pragma unroll 1
                for (int kt = wave; kt < nkt; kt += 8) {
                    bf8 ac[4];
#pragma unroll
                    for (int s = 0; s < 4; ++s) ac[s] = an[s];
                    load_tile(kt + 8 < nkt ? kt + 8 : kt, an);
                    f32x16 sc; score_tile(ac, sc);
#pragma unroll
                    for (int reg = 0; reg < 16; ++reg) {
                        const u32 u = __float_as_uint(sc[reg]);
                        const u32 key = (u & 0x80000000u) ? ~u : (u | 0x80000000u);
                        const u32 idx = kt * 32 + (reg & 3) + 8 * (reg >> 2) + 4 * hh;
                        const u64 K = ((u64)bin_of(sc[reg]) << 54) | ((u64)sub_of(sc[reg]) << 46) | ((u64)key << 14) | (u64)(16383u - idx);
                        if (!qdone && (K >> sh_hi) == pref) atomicAdd(&hist[q * HST + (u32)((K >> sh) & dmask)], 1u);
                    }
                }
            }
            __syncthreads();
            if (lane == 0) flag[wave] = 0;
            auto find_cross = [&](const u32* hrow, u32 r, u32& digit, u32& ac, u32& bucket) {
                uint4 h4; h4.x = hrow[lane * 4]; h4.y = hrow[lane * 4 + 1]; h4.z = hrow[lane * 4 + 2]; h4.w = hrow[lane * 4 + 3];
                const u32 s4 = h4.x + h4.y + h4.z + h4.w; u32 v = s4;
#pragma unroll
                for (int off = 1; off < 64; off <<= 1) { const u32 t = __shfl_down(v, off); if (lane + off < 64) v += t; }
                const u32 above = v - s4;
                const bool hit = above < r && r <= v;
                u32 a = above; u32 d, bk;
                if (a + h4.w >= r) { d = 3; bk = h4.w; }
                else { a += h4.w; if (a + h4.z >= r) { d = 2; bk = h4.z; }
                    else { a += h4.z; if (a + h4.y >= r) { d = 1; bk = h4.y; } else { a += h4.y; d = 0; bk = h4.x; } } }
                const u64 mk = __ballot(hit);
                const int src_lane = mk ? (__ffsll((long long)mk) - 1) : 0;
                digit = __shfl((u32)(lane * 4) + d, src_lane); ac = __shfl(a, src_lane); bucket = __shfl(bk, src_lane);
            };
#pragma unroll 1
            for (int j = 0; j < 4; ++j) {
                const int qq = 4 * wave + j;
                if (st[3 * 32 + qq] != 0) continue;
                const u32 r = st[2 * 32 + qq];
                u32 digit, ac, bucket;
                find_cross(hist + qq * HST, r, digit, ac, bucket);
                u32 pdig = digit;
                u32 shv = (u32)sh, rn = r - ac, cls = (level == 0) ? 0u : 2u;
                bool dn = (bucket <= (u32)CAP) || (level == 7);
                if (!dn && level == 0) {
                    if (digit == 128u) {
                        const u32* h2 = hist2 + qq * HST;
                        u32 nz = h2[lane * 4] + h2[lane * 4 + 1] + h2[lane * 4 + 2] + h2[lane * 4 + 3];
#pragma unroll
                        for (int off = 1; off < 64; off <<= 1) nz += __shfl_xor(nz, off);
                        const u32 npos = bucket - nz;
                        if (rn > npos) {
                            u32 d2, ac2, bk2;
                            find_cross(h2, rn - npos, d2, ac2, bk2);
                            pdig = d2; shv = 6u; rn = rn - npos - ac2; cls = 1u; dn = true;
                        }
                    }
                }
                if (lane == 0) {
                    u64 pf;
                    if (cls == 1u) pf = ((u64)128u << 48) | ((u64)0x80000000u << 8) | (u64)pdig;
                    else { pf = ((u64)st[1 * 32 + qq] << 32) | st[0 * 32 + qq]; pf = (pf << bits) | (u64)pdig; }
                    st[0 * 32 + qq] = (u32)pf; st[1 * 32 + qq] = (u32)(pf >> 32);
                    st[2 * 32 + qq] = rn; st[3 * 32 + qq] = dn ? 1u : 0u; st[6 * 32 + qq] = shv; st[7 * 32 + qq] = cls;
                    if (!dn) flag[wave] = 1;
                }
            }
            __syncthreads();
            u32 any = 0;
#pragma unroll
            for (int i = 0; i < 8; ++i) any |= flag[i];
            if (!any) break;
        }
        __syncthreads();
        {
            const u64 pref = ((u64)st[1 * 32 + q] << 32) | st[0 * 32 + q];
            const int shq = (int)st[6 * 32 + q];
            const u32 cls = st[7 * 32 + q];
            bf8 an[4]; load_tile(wave < nkt ? wave : 0, an);
            if (level == 0) {
                const bool cls1 = (cls == 1u);
                const u32 pb = cls1 ? 128u : (u32)pref;
                auto key_to_float = [&](u32 k) -> float { return __uint_as_float((k & 0x80000000u) ? (k ^ 0x80000000u) : ~k); };
                auto first_score_with_bin = [&](u32 B) -> float {
                    u32 lo = 0x007FFFFFu, hi = 0xFF800000u;
                    if (bin_of(key_to_float(hi)) < B) return __builtin_inff();
#pragma unroll 1
                    for (int it = 0; it < 32; ++it) {
                        if (lo >= hi) break;
                        const u32 mid = lo + ((hi - lo) >> 1);
                        if (bin_of(key_to_float(mid)) >= B) hi = mid; else lo = mid + 1;
                    }
                    return key_to_float(hi);
                };
                const float vs = cls1 ? 1.4e-45f : first_score_with_bin(pb + 1u);
                const float vc = cls1 ? __builtin_inff() : first_score_with_bin(pb);
                const u32 d2q = (u32)pref & 0xFFu;
#pragma unroll 1
                for (int kt = wave; kt < nkt; kt += 8) {
                    bf8 ac[4];
#pragma unroll
                    for (int s = 0; s < 4; ++s) ac[s] = an[s];
                    load_tile(kt + 8 < nkt ? kt + 8 : kt, an);
                    f32x16 sc; score_tile(ac, sc);
                    const u32 dgt = 255u - (u32)(kt >> 1);
                    const bool zsel = cls1 && dgt > d2q, zcand = cls1 && dgt == d2q;
                    u32 smask = 0;
#pragma unroll
                    for (int reg = 0; reg < 16; ++reg) {
                        const float v = sc[reg];
                        const bool z = (v == 0.f);
                        const bool s1 = (v >= vs) || (z && zsel);
                        const bool c1 = (!s1) && ((v >= vc) || (z && zcand));
                        smask |= s1 ? (1u << reg) : 0u;
                        if (c1) {
                            const u32 idx = kt * 32 + (reg & 3) + 8 * (reg >> 2) + 4 * hh;
                            const u32 pos = atomicAdd(&st[5 * 32 + q], 1u);
                            if (pos < (u32)CAP) { const u32 u = __float_as_uint(v); ckey[q * CAP + pos] = (u & 0x80000000u) ? ~u : (u | 0x80000000u); cidx[q * CAP + pos] = idx; }
                        }
                    }
                    if (smask) {
                        u32 pos = atomicAdd(&st[4 * 32 + q], (u32)__popc(smask));
                        while (smask) {
                            const int reg = __ffs((int)smask) - 1; smask &= smask - 1;
                            const u32 idx = kt * 32 + (reg & 3) + 8 * (reg >> 2) + 4 * hh;
                            if (pos < 256) sel[q * 256 + pos] = (u16)idx;
                            ++pos;
                        }
                    }
                }
            } else {
#pragma unroll 1
                for (int kt = wave; kt < nkt; kt += 8) {
                    bf8 ac[4];
#pragma unroll
                    for (int s = 0; s < 4; ++s) ac[s] = an[s];
                    load_tile(kt + 8 < nkt ? kt + 8 : kt, an);
                    f32x16 sc; score_tile(ac, sc);
#pragma unroll
                    for (int reg = 0; reg < 16; ++reg) {
                        const u32 u = __float_as_uint(sc[reg]);
                        const u32 key = (u & 0x80000000u) ? ~u : (u | 0x80000000u);
                        const u32 idx = kt * 32 + (reg & 3) + 8 * (reg >> 2) + 4 * hh;
                        const u64 K = ((u64)bin_of(sc[reg]) << 54) | ((u64)sub_of(sc[reg]) << 46) | ((u64)key << 14) | (u64)(16383u - idx);
                        const u64 e = K >> shq;
                        if (e >= pref) {
                            if (e > pref) { const u32 pos = atomicAdd(&st[4 * 32 + q], 1u); if (pos < 256) sel[q * 256 + pos] = (u16)idx; }
                            else { const u32 pos = atomicAdd(&st[5 * 32 + q], 1u); if (pos < (u32)CAP) { ckey[q * CAP + pos] = key; cidx[q * CAP + pos] = idx; } }
                        }
                    }
                }
            }
        }
        __syncthreads();
#pragma unroll 1
        for (int j = 0; j < 4; ++j) {
            const int qq = 4 * wave + j;
            const u32 nc = min(st[5 * 32 + qq], (u32)CAP), r = st[2 * 32 + qq];
            u32 ki[4], ii[4], rk[4];
#pragma unroll
            for (int t = 0; t < 4; ++t) { const u32 i = lane + 64 * t; ki[t] = i < nc ? ckey[qq * CAP + i] : 0u; ii[t] = i < nc ? cidx[qq * CAP + i] : 0xFFFFFFFFu; rk[t] = 0; }
            for (u32 jj = 0; jj < nc; ++jj) {
                const u32 kj = ckey[qq * CAP + jj], ij = cidx[qq * CAP + jj];
#pragma unroll
                for (int t = 0; t < 4; ++t) rk[t] += (kj > ki[t] || (kj == ki[t] && ij < ii[t])) ? 1u : 0u;
            }
#pragma unroll
            for (int t = 0; t < 4; ++t) {
                const u32 i = lane + 64 * t;
                if (i < nc && rk[t] < r) { const u32 pos = atomicAdd(&st[4 * 32 + qq], 1u); if (pos < 256) sel[qq * 256 + pos] = (u16)ii[t]; }
            }
        }
    }
    }
    __syncthreads();
    {
        u16* SELG = (u16*)(ws_ + OFF_SEL) + (size_t)t0 * 256;
        for (int i = tid; i < 32 * 256 / 8; i += 512) *(uint4*)(SELG + i * 8) = *(const uint4*)(sel + i * 8);
    }
    __syncthreads();
}

constexpr int T_SEL = 0, T_PL = 8 * 512, T_RED = T_PL + 8 * 4096;
__device__ __forceinline__ void att_unit(const Params& p, int c, int hf, int g, unsigned char* smem) {
    unsigned char* ws_ = opaque_ptr(p.ws);
    const int tid = opaque_tid(), lane = tid & 63, wave = tid >> 6;
    const u16* P = (const u16*)(ws_ + OFF_P); const unsigned char* KV8 = (const unsigned char*)(ws_ + OFF_KVA); u16* YBR = (u16*)(ws_ + OFF_YBR);
    const u16* SELG = (const u16*)(ws_ + OFF_SEL);
    const int t0 = c * 64 + hf * 32;
    const int nadm = 64 * (c + 1);
    const int nvalid = nadm < 256 ? nadm : 256;
    u16* selw = (u16*)(smem + T_SEL) + wave * 256;
    float* pl = (float*)(smem + T_PL) + wave * 1024;
    const int hc = lane & 15, lg = lane >> 4;
    __syncthreads();
    for (int rep_att = 0; rep_att < DUP_AATT; ++rep_att) {
#pragma unroll 1
    for (int j = 0; j < 4; ++j) {
        const size_t tq = (size_t)(t0 + 4 * wave + j);
        *(uint2*)(selw + lane * 4) = *(const uint2*)(SELG + tq * 256 + lane * 4);
        uint4 qn0 = make_uint4(0, 0, 0, 0), qn1 = qn0;
        if (hc < 4) { const u16* qp = P + tq * PLD + C_AQ + (g * 4 + hc) * 64 + lg * 8; qn0 = *(const uint4*)qp; qn1 = *(const uint4*)(qp + 32); }
        long bqa[2];
        {
            int a0 = __builtin_amdgcn_cvt_pk_fp8_f32(bflo(qn0.x), bfhi(qn0.x), 0, false); a0 = __builtin_amdgcn_cvt_pk_fp8_f32(bflo(qn0.y), bfhi(qn0.y), a0, true);
            int a1 = __builtin_amdgcn_cvt_pk_fp8_f32(bflo(qn0.z), bfhi(qn0.z), 0, false); a1 = __builtin_amdgcn_cvt_pk_fp8_f32(bflo(qn0.w), bfhi(qn0.w), a1, true);
            int c0 = __builtin_amdgcn_cvt_pk_fp8_f32(bflo(qn1.x), bfhi(qn1.x), 0, false); c0 = __builtin_amdgcn_cvt_pk_fp8_f32(bflo(qn1.y), bfhi(qn1.y), c0, true);
            int c1 = __builtin_amdgcn_cvt_pk_fp8_f32(bflo(qn1.z), bfhi(qn1.z), 0, false); c1 = __builtin_amdgcn_cvt_pk_fp8_f32(bflo(qn1.w), bfhi(qn1.w), c1, true);
            bqa[0] = (long)(((unsigned long long)(unsigned)a1 << 32) | (unsigned)a0);
            bqa[1] = (long)(((unsigned long long)(unsigned)c1 << 32) | (unsigned)c0);
        }
        __builtin_amdgcn_fence(__ATOMIC_RELEASE, "workgroup");
        __builtin_amdgcn_wave_barrier();
        __builtin_amdgcn_fence(__ATOMIC_ACQUIRE, "workgroup");
        const int ks = lane >> 3, dc = lane & 7;
        const unsigned char* vb = KV8 + 128 + g * 64 + dc * 8;
        uint2 vvs[32];
#pragma unroll
        for (int it = 0; it < 32; ++it) vvs[it] = *(const uint2*)(vb + (size_t)selw[it * 8 + ks] * 256);
        f32x4 sacc[16];
#pragma unroll
        for (int kt = 0; kt < 16; ++kt) {
            const u32 idx = selw[kt * 16 + hc];
            const unsigned char* kr = KV8 + (size_t)idx * 256 + g * 64 + lg * 8;
            const long a0 = *(const long*)kr, a1 = *(const long*)(kr + 32);
            f32x4 z = {0.f, 0.f, 0.f, 0.f};
            z = __builtin_amdgcn_mfma_f32_16x16x32_fp8_fp8(a0, bqa[0], z, 0, 0, 0);
            sacc[kt] = __builtin_amdgcn_mfma_f32_16x16x32_fp8_fp8(a1, bqa[1], z, 0, 0, 0);
        }
        if (hc < 4) {
#pragma unroll
            for (int kt = 0; kt < 16; ++kt)
#pragma unroll
                for (int r = 0; r < 4; ++r) pl[(kt * 16 + lg * 4 + r) * 4 + hc] = sacc[kt][r];
        }
        __builtin_amdgcn_fence(__ATOMIC_RELEASE, "workgroup");
        __builtin_amdgcn_wave_barrier();
        __builtin_amdgcn_fence(__ATOMIC_ACQUIRE, "workgroup");
        {
            f32x4 lv[4];
            f32x4 mh = {-INFINITY, -INFINITY, -INFINITY, -INFINITY};
#pragma unroll
            for (int i = 0; i < 4; ++i) {
                const f32x4 raw = *(const f32x4*)&pl[(lane * 4 + i) * 4];
                const bool valid = (lane * 4 + i) < nvalid;
#pragma unroll
                for (int hq = 0; hq < 4; ++hq) { lv[i][hq] = valid ? raw[hq] * 0.125f : -INFINITY; mh[hq] = fmaxf(mh[hq], lv[i][hq]); }
            }
#pragma unroll
            for (int hq = 0; hq < 4; ++hq)
#pragma unroll
                for (int off = 1; off < 64; off <<= 1) mh[hq] = fmaxf(mh[hq], __shfl_xor(mh[hq], off));
            f32x4 sh = {0.f, 0.f, 0.f, 0.f};
#pragma unroll
            for (int i = 0; i < 4; ++i)
#pragma unroll
                for (int hq = 0; hq < 4; ++hq) { const float e = __expf(lv[i][hq] - mh[hq]); lv[i][hq] = e; sh[hq] += e; }
#pragma unroll
            for (int hq = 0; hq < 4; ++hq)
#pragma unroll
                for (int off = 1; off < 64; off <<= 1) sh[hq] += __shfl_xor(sh[hq], off);
            const f32x4 inv = {1.f / sh[0], 1.f / sh[1], 1.f / sh[2], 1.f / sh[3]};
#pragma unroll
            for (int i = 0; i < 4; ++i) *(f32x4*)&pl[(lane * 4 + i) * 4] = lv[i] * inv;
        }
        __builtin_amdgcn_fence(__ATOMIC_RELEASE, "workgroup");
        __builtin_amdgcn_wave_barrier();
        __builtin_amdgcn_fence(__ATOMIC_ACQUIRE, "workgroup");
        {
            typedef float f32x2 __attribute__((ext_vector_type(2)));
            f32x2 o[4][4];
#pragma unroll
            for (int hq = 0; hq < 4; ++hq)
#pragma unroll
                for (int e = 0; e < 4; ++e) o[hq][e] = (f32x2){0.f, 0.f};
#pragma unroll
            for (int it = 0; it < 32; ++it) {
                const int n = it * 8 + ks;
                const uint2 vv = vvs[it];
                const float4 p4 = *(const float4*)&pl[n * 4];
                f32x2 v[4];
                v[0] = __builtin_amdgcn_cvt_pk_f32_fp8((int)vv.x, false); v[1] = __builtin_amdgcn_cvt_pk_f32_fp8((int)vv.x, true);
                v[2] = __builtin_amdgcn_cvt_pk_f32_fp8((int)vv.y, false); v[3] = __builtin_amdgcn_cvt_pk_f32_fp8((int)vv.y, true);
#pragma unroll
                for (int e = 0; e < 4; ++e) { o[0][e] += v[e] * p4.x; o[1][e] += v[e] * p4.y; o[2][e] += v[e] * p4.z; o[3][e] += v[e] * p4.w; }
            }
            float* red = (float*)(smem + T_RED) + wave * 2048;
#pragma unroll
            for (int hq = 0; hq < 4; ++hq) {
                *(f32x4*)&red[(ks * 4 + hq) * 64 + dc * 8] = (f32x4){o[hq][0].x, o[hq][0].y, o[hq][1].x, o[hq][1].y};
                *(f32x4*)&red[(ks * 4 + hq) * 64 + dc * 8 + 4] = (f32x4){o[hq][2].x, o[hq][2].y, o[hq][3].x, o[hq][3].y};
            }
            __builtin_amdgcn_fence(__ATOMIC_RELEASE, "workgroup");
            __builtin_amdgcn_wave_barrier();
            __builtin_amdgcn_fence(__ATOMIC_ACQUIRE, "workgroup");
            {
                const int hq = lane >> 4, d4 = (lane & 15) * 4;
                f32x4 acc4 = {0.f, 0.f, 0.f, 0.f};
#pragma unroll
                for (int k2 = 0; k2 < 8; ++k2) acc4 += *(const f32x4*)&red[(k2 * 4 + hq) * 64 + d4];
                const int col = (g * 4 + hq) * 64 + d4;
                const uint2 zz = *(const uint2*)(P + tq * PLD + C_AZ + col);
                uint2 yy;
                yy.x = pk2(acc4[0] * siluf(bflo(zz.x)), acc4[1] * siluf(bfhi(zz.x))); yy.y = pk2(acc4[2] * siluf(bflo(zz.y)), acc4[3] * siluf(bfhi(zz.y)));
                *(uint2*)(YBR + tq * 1536 + col) = yy;
            }
        }
        __builtin_amdgcn_fence(__ATOMIC_RELEASE, "workgroup");
        __builtin_amdgcn_wave_barrier();
        __builtin_amdgcn_fence(__ATOMIC_ACQUIRE, "workgroup");
    }
    }
    __syncthreads();
}

constexpr int B_BIAS = 0, B_V = 8448;
__device__ __forceinline__ void b_unit(const Params& p, int l, int c, unsigned char* smem) {
    unsigned char* ws_ = opaque_ptr(p.ws);
    const int tid = opaque_tid(), lane = tid & 63, wave = tid >> 6;
    const int q = lane & 31, hh = lane >> 5;
    const u16* P = (const u16*)(ws_ + OFF_P); u16* YBR = (u16*)(ws_ + OFF_YBR);
    float* bt = (float*)(smem + B_BIAS);
    __syncthreads();
    for (int i = tid; i < 8 * 257; i += 512) bt[i] = p.rel_bias[l * 8 * 257 + i];
    __syncthreads();
    const int h = wave;
    const float* bth = bt + h * 257;
    unsigned char* vl = smem + B_V + wave * (64 * 144);
    const int tc = c * 64;
    bf8 bq[2][4];
#pragma unroll
    for (int nt = 0; nt < 2; ++nt)
#pragma unroll
        for (int ks = 0; ks < 4; ++ks) bq[nt][ks] = ld_bf8(P + (size_t)(tc + nt * 32 + q) * PLD + C_BQ + h * 64 + ks * 16 + hh * 8);
    f32x16 oacc[2][2];
#pragma unroll
    for (int i = 0; i < 2; ++i)
#pragma unroll
        for (int j = 0; j < 2; ++j)
#pragma unroll
            for (int e = 0; e < 16; ++e) oacc[i][j][e] = 0.f;
    float mrun[2] = {-INFINITY, -INFINITY}, lsum[2] = {0.f, 0.f};
    const int g16 = lane >> 4, i16 = lane & 15, qrow = i16 >> 2, pp = i16 & 3, hp = g16 >> 1;
#pragma unroll 1
    for (int kc = (c < 8 ? 8 - c : 0); kc <= 8; ++kc) {
        const int kch = c - 8 + kc;
#pragma unroll
        for (int i = 0; i < 8; ++i) {
            const int id = lane + 64 * i, row = id >> 3, ch = id & 7;
            *(uint4*)(vl + row * 144 + ch * 16) = *(const uint4*)(P + (size_t)(kch * 64 + row) * PLD + C_BV + h * 64 + ch * 8);
        }
        f32x16 s[2][2];
#pragma unroll
        for (int mt = 0; mt < 2; ++mt) {
            bf8 ak[4];
#pragma unroll
            for (int ks = 0; ks < 4; ++ks) ak[ks] = ld_bf8(P + (size_t)(kch * 64 + mt * 32 + q) * PLD + C_BK + h * 64 + ks * 16 + hh * 8);
#pragma unroll
            for (int nt = 0; nt < 2; ++nt) {
#pragma unroll
                for (int e = 0; e < 16; ++e) s[mt][nt][e] = 0.f;
#pragma unroll
                for (int ks = 0; ks < 4; ++ks) s[mt][nt] = mfma32(ak[ks], bq[nt][ks], s[mt][nt]);
            }
        }
#pragma unroll
        for (int nt = 0; nt < 2; ++nt) {
            const int qi = nt * 32 + q;
            float tmax = -INFINITY;
            if (kc <= 5) {
                const float bfar = bth[256];
#pragma unroll
                for (int mt = 0; mt < 2; ++mt)
#pragma unroll
                    for (int reg = 0; reg < 16; ++reg) { const float v = fmaf(s[mt][nt][reg], 0.125f, bfar); s[mt][nt][reg] = v; tmax = fmaxf(tmax, v); }
            } else {
#pragma unroll
                for (int mt = 0; mt < 2; ++mt)
#pragma unroll
                    for (int reg = 0; reg < 16; ++reg) {
                        const int kk = mt * 32 + (reg & 3) + 8 * (reg >> 2) + 4 * hh;
                        int rel = 512 + qi - (kc * 64 + kk);
                        rel = rel > 128 ? 128 : rel; rel = rel < -128 ? -128 : rel;
                        const float v = s[mt][nt][reg] * 0.125f + bth[rel + 128];
                        s[mt][nt][reg] = v; tmax = fmaxf(tmax, v);
                    }
            }
            tmax = fmaxf(tmax, __shfl_xor(tmax, 32));
            const float mnew = fmaxf(mrun[nt], tmax);
            const float alpha = __expf(mrun[nt] - mnew);
            mrun[nt] = mnew;
            float ps = 0.f;
#pragma unroll
            for (int mt = 0; mt < 2; ++mt)
#pragma unroll
                for (int reg = 0; reg < 16; ++reg) { const float e = __expf(s[mt][nt][reg] - mnew); s[mt][nt][reg] = e; ps += e; }
            lsum[nt] = lsum[nt] * alpha + ps;
#pragma unroll
            for (int dmt = 0; dmt < 2; ++dmt)
#pragma unroll
                for (int e = 0; e < 16; ++e) oacc[dmt][nt][e] *= alpha;
        }
        __builtin_amdgcn_fence(__ATOMIC_RELEASE, "workgroup");
        __builtin_amdgcn_wave_barrier();
        __builtin_amdgcn_fence(__ATOMIC_ACQUIRE, "workgroup");
#pragma unroll
        for (int mt = 0; mt < 2; ++mt)
#pragma unroll
            for (int sp = 0; sp < 2; ++sp) {
                const int rb = mt * 32 + 16 * sp + 4 * hp + qrow;
                bf8 av[2];
#pragma unroll
                for (int dmt = 0; dmt < 2; ++dmt) {
                    const unsigned char* a0 = vl + rb * 144 + (dmt * 32 + 16 * (g16 & 1) + 4 * pp) * 2;
                    av[dmt] = tr_pair(a0, a0 + 8 * 144);
                }
#pragma unroll
                for (int nt = 0; nt < 2; ++nt) {
                    const bf8 bp = pack8(s[mt][nt][8 * sp + 0], s[mt][nt][8 * sp + 1], s[mt][nt][8 * sp + 2], s[mt][nt][8 * sp + 3],
                                         s[mt][nt][8 * sp + 4], s[mt][nt][8 * sp + 5], s[mt][nt][8 * sp + 6], s[mt][nt][8 * sp + 7]);
#pragma unroll
                    for (int dmt = 0; dmt < 2; ++dmt) oacc[dmt][nt] = mfma32(av[dmt], bp, oacc[dmt][nt]);
                }
            }
        __builtin_amdgcn_fence(__ATOMIC_RELEASE, "workgroup");
        __builtin_amdgcn_wave_barrier();
        __builtin_amdgcn_fence(__ATOMIC_ACQUIRE, "workgroup");
    }
#pragma unroll
    for (int nt = 0; nt < 2; ++nt) {
        const float lt = lsum[nt] + __shfl_xor(lsum[nt], 32);
        const float inv = 1.f / lt;
        const size_t t = (size_t)(tc + nt * 32 + q);
#pragma unroll
        for (int dmt = 0; dmt < 2; ++dmt)
#pragma unroll
            for (int rg = 0; rg < 4; ++rg) {
                const int d0 = dmt * 32 + 8 * rg + 4 * hh;
                const uint2 zz = *(const uint2*)(P + t * PLD + C_BZ + h * 64 + d0);
                const float y0 = oacc[dmt][nt][4 * rg + 0] * inv * siluf(bflo(zz.x));
                const float y1 = oacc[dmt][nt][4 * rg + 1] * inv * siluf(bfhi(zz.x));
                const float y2 = oacc[dmt][nt][4 * rg + 2] * inv * siluf(bflo(zz.y));
                const float y3 = oacc[dmt][nt][4 * rg + 3] * inv * siluf(bfhi(zz.y));
                *(uint2*)(YBR + t * 1536 + 512 + h * 64 + d0) = make_uint2(pk2(y0, y1), pk2(y2, y3));
            }
    }
    __syncthreads();
}

__device__ __forceinline__ void conv8w(const u16* __restrict__ P, int t, int col, const float* __restrict__ cwl, const float* __restrict__ cbl, int cch, float (&out)[8]) {
    {
        const float4 a = *(const float4*)(cbl + cch), b = *(const float4*)(cbl + cch + 4);
        out[0] = a.x; out[1] = a.y; out[2] = a.z; out[3] = a.w; out[4] = b.x; out[5] = b.y; out[6] = b.z; out[7] = b.w;
    }
#pragma unroll
    for (int j = 0; j < 4; ++j) {
        const int tr = t - 3 + j;
        if (tr >= 0) {
            const float4 a = *(const float4*)(cwl + j * 1024 + cch), b = *(const float4*)(cwl + j * 1024 + cch + 4);
            const uint4 rw = *(const uint4*)(P + (size_t)tr * PLD + col);
            out[0] = fmaf(a.x, bflo(rw.x), out[0]); out[1] = fmaf(a.y, bfhi(rw.x), out[1]);
            out[2] = fmaf(a.z, bflo(rw.y), out[2]); out[3] = fmaf(a.w, bfhi(rw.y), out[3]);
            out[4] = fmaf(b.x, bflo(rw.z), out[4]); out[5] = fmaf(b.y, bfhi(rw.z), out[5]);
            out[6] = fmaf(b.z, bflo(rw.w), out[6]); out[7] = fmaf(b.w, bfhi(rw.w), out[7]);
        }
    }
#pragma unroll
    for (int e = 0; e < 8; ++e) out[e] = siluf(out[e]);
}
__device__ __forceinline__ float scan_sum64(float v, int lane) {
#pragma unroll
    for (int o = 1; o < 64; o <<= 1) { const float t = __shfl_up(v, o); if (lane >= o) v += t; }
    return v;
}
__device__ __forceinline__ float scan_max64(float v, int lane) {
#pragma unroll
    for (int o = 1; o < 64; o <<= 1) { const float t = __shfl_up(v, o); if (lane >= o) v = fmaxf(v, t); }
    return v;
}
constexpr int ROWB = 288;
constexpr int C1_TW = 0, C1_K = 1024, C1_V = 1024 + 2 * 64 * ROWB;
__device__ __forceinline__ void c1_unit(const Params& p, int l, int c, unsigned char* smem) {
    unsigned char* ws_ = opaque_ptr(p.ws);
    const int tid = opaque_tid(), lane = tid & 63, wave = tid >> 6;
    const u16* P = (const u16*)(ws_ + OFF_P); const float* SM = (const float*)(ws_ + OFF_SM);
    float* KVS = (float*)(ws_ + OFF_KVS); float* NS = (float*)(ws_ + OFF_NS); float* GC = (float*)(ws_ + OFF_GC); float* ML = (float*)(ws_ + OFF_ML);
    const float* cwl = p.conv_w + (size_t)l * 4 * 1024; const float* cbl = p.conv_b + (size_t)l * 1024;
    float* tw = (float*)(smem + C1_TW);
    const int tc = c * 64;
    const int g16 = lane >> 4, i16 = lane & 15, qrow = i16 >> 2, pp = i16 & 3, hp = g16 >> 1;
#pragma unroll 1
    for (int hpair = 0; hpair < 2; ++hpair) {
        __syncthreads();
        if ((wave & 3) == 0) {
            const int hl = wave >> 2, h = 2 * hpair + hl;
            const float fpre = SM[(size_t)(tc + lane) * 16 + 8 + h], ipre = SM[(size_t)(tc + lane) * 16 + 4 + h];
            const float bcum = scan_sum64(logsigmoidf(fpre), lane);
            const float u = ipre - bcum;
            const float umax = wave_max(u);
            tw[hl * 64 + lane] = __expf(u - umax);
            if (lane == 63) { GC[h * NCH + c] = bcum; ML[h * NCH + c] = bcum + umax; }
        }
        __syncthreads();
#pragma unroll 1
        for (int i = 0; i < 4; ++i) {
            const int item = tid + 512 * i, hl = item >> 10, row = (item >> 4) & 63, ch = item & 15, h = 2 * hpair + hl;
            float o[8];
            conv8w(P, tc + row, C_CK + h * 128 + ch * 8, cwl, cbl, 512 + h * 128 + ch * 8, o);
            {
                u16* KC = (u16*)(ws_ + OFF_MG) + (size_t)SEQ * 512; u16* QC = (u16*)(ws_ + OFF_MG);
                uint4 kc; kc.x = pk2(o[0], o[1]); kc.y = pk2(o[2], o[3]); kc.z = pk2(o[4], o[5]); kc.w = pk2(o[6], o[7]);
                *(uint4*)(KC + (size_t)(tc + row) * 512 + h * 128 + ch * 8) = kc;
                float oq[8];
                conv8w(P, tc + row, C_CQ + h * 128 + ch * 8, cwl, cbl, h * 128 + ch * 8, oq);
                const float qs = 0.08838834764831845f;
                uint4 qc; qc.x = pk2(oq[0] * qs, oq[1] * qs); qc.y = pk2(oq[2] * qs, oq[3] * qs); qc.z = pk2(oq[4] * qs, oq[5] * qs); qc.w = pk2(oq[6] * qs, oq[7] * qs);
                *(uint4*)(QC + (size_t)(tc + row) * 512 + h * 128 + ch * 8) = qc;
            }
            const float wg = tw[hl * 64 + row];
            uint4 kk; kk.x = pk2(o[0] * wg, o[1] * wg); kk.y = pk2(o[2] * wg, o[3] * wg); kk.z = pk2(o[4] * wg, o[5] * wg); kk.w = pk2(o[6] * wg, o[7] * wg);
            *(uint4*)(smem + C1_K + hl * 64 * ROWB + row * ROWB + ch * 16) = kk;
            *(uint4*)(smem + C1_V + hl * 64 * ROWB + row * ROWB + ch * 16) = *(const uint4*)(P + (size_t)(tc + row) * PLD + C_CV + h * 128 + ch * 8);
        }
        __syncthreads();
        {
            const int hl = wave >> 2, ws = wave & 3, h = 2 * hpair + hl;
            const unsigned char* kb = smem + C1_K + hl * 64 * ROWB; const unsigned char* vb = smem + C1_V + hl * 64 * ROWB;
            f32x16 acc[5];
#pragma unroll
            for (int i = 0; i < 5; ++i)
#pragma unroll
                for (int e = 0; e < 16; ++e) acc[i][e] = 0.f;
            const bf8 ones = pack8(1.f, 1.f, 1.f, 1.f, 1.f, 1.f, 1.f, 1.f), zeros = pack8(0.f, 0.f, 0.f, 0.f, 0.f, 0.f, 0.f, 0.f);
            const bf8 aext = ((lane & 31) == 0) ? ones : zeros;
#pragma unroll
            for (int ks = 0; ks < 4; ++ks) {
                const int rb = 16 * ks + 8 * hp + qrow;
                const unsigned char* b0 = kb + rb * ROWB + (32 * ws + 16 * (g16 & 1) + 4 * pp) * 2;
                const bf8 bfr = tr_pair(b0, b0 + 4 * ROWB);
#pragma unroll
                for (int emt = 0; emt < 4; ++emt) {
                    const unsigned char* a0 = vb + rb * ROWB + (32 * emt + 16 * (g16 & 1) + 4 * pp) * 2;
                    const bf8 afr = tr_pair(a0, a0 + 4 * ROWB);
                    acc[emt] = mfma32(afr, bfr, acc[emt]);
                }
                acc[4] = mfma32(aext, bfr, acc[4]);
            }
            float* ct = KVS + ((size_t)(h * NCH + c) * 128) * 128;
            const int d = 32 * ws + (lane & 31);
#pragma unroll
            for (int emt = 0; emt < 4; ++emt)
#pragma unroll
                for (int reg = 0; reg < 16; ++reg) {
                    const int e = emt * 32 + (reg & 3) + 8 * (reg >> 2) + 4 * (lane >> 5);
                    ct[(size_t)e * 128 + d] = acc[emt][reg];
                }
            if ((lane >> 5) == 0) NS[(size_t)(h * NCH + c) * 128 + d] = acc[4][0];
        }
    }
    __syncthreads();
}
__device__ __forceinline__ void m2_unit(const Params& p, int item, unsigned char* smem) {
    unsigned char* ws_ = opaque_ptr(p.ws);
    const int tid = opaque_tid();
    float* KVS = (float*)(ws_ + OFF_KVS); float* NS = (float*)(ws_ + OFF_NS);
    const float* GC = (const float*)(ws_ + OFF_GC); const float* ML = (const float*)(ws_ + OFF_ML); float* MP = (float*)(ws_ + OFF_MP);
    float* sa = (float*)smem; float* sb = sa + 1024;
    {
        __syncthreads();
        for (int i = tid; i < 1024; i += 512) { sa[i] = GC[i]; sb[i] = ML[i]; }
        __syncthreads();
        if (tid < 4) {
            const int h = tid; float m = 0.f;
            for (int c = 0; c < NCH; ++c) {
                const float g = sa[h * NCH + c], ml = sb[h * NCH + c];
                const float mn = fmaxf(g + m, ml);
                sa[h * NCH + c] = __expf(g + m - mn); sb[h * NCH + c] = __expf(ml - mn);
                if (item == 256) MP[h * NCH + c] = m;
                m = mn;
            }
        }
        __syncthreads();
        if (item < 256) {
            if (tid < 256) {
                const int h = item >> 6, idx = (item & 63) * 256 + tid;
                float* base = KVS + (size_t)h * NCH * 16384 + idx;
                u16* baseb = (u16*)(ws_ + OFF_CTB) + (size_t)h * NCH * 16384 + idx;
                const float* a = sa + h * NCH; const float* bb = sb + h * NCH;
                float C = 0.f;
#pragma unroll 1
                for (int c0 = 0; c0 < NCH; c0 += 32) {
                    float kv[32];
#pragma unroll
                    for (int j = 0; j < 32; ++j) kv[j] = base[(size_t)(c0 + j) * 16384];
#pragma unroll
                    for (int j = 0; j < 32; ++j) { baseb[(size_t)(c0 + j) * 16384] = f2bf(C); C = a[c0 + j] * C + bb[c0 + j] * kv[j]; }
                }
            }
        } else {
            const int h = tid >> 7, d = tid & 127;
            float* base = NS + (size_t)h * NCH * 128 + d;
            float n = 0.f;
#pragma unroll 1
            for (int c0 = 0; c0 < NCH; c0 += 16) {
                float ks[16];
#pragma unroll
                for (int j = 0; j < 16; ++j) ks[j] = base[(size_t)(c0 + j) * 128];
#pragma unroll
                for (int j = 0; j < 16; ++j) { base[(size_t)(c0 + j) * 128] = n; n = sa[h * NCH + c0 + j] * n + sb[h * NCH + c0 + j] * ks[j]; }
            }
        }
    }
    __syncthreads();
}
constexpr int C3_V = 0, C3_TB = 4 * 64 * ROWB, C3_BQ = C3_TB + 8 * 768;
static_assert(C3_BQ + 8 * 8192 <= LDS_BYTES, "c3 lds");
__device__ __forceinline__ void c3_unit(const Params& p, int l, int c, unsigned char* smem) {
    unsigned char* ws_ = opaque_ptr(p.ws);
    const int tid = opaque_tid(), lane = tid & 63, wave = tid >> 6;
    const int q = lane & 31, hh = lane >> 5;
    const u16* P = (const u16*)(ws_ + OFF_P); const float* SM = (const float*)(ws_ + OFF_SM); u16* YBR = (u16*)(ws_ + OFF_YBR);
    const float* KVS = (const float*)(ws_ + OFF_KVS); const float* NS = (const float*)(ws_ + OFF_NS); const float* MP = (const float*)(ws_ + OFF_MP);
    const float* cwl = p.conv_w + (size_t)l * 4 * 1024; const float* cbl = p.conv_b + (size_t)l * 1024;
    const int tc = c * 64;
    const int h = wave >> 1, qh = wave & 1;
    __syncthreads();
#pragma unroll 1
    for (int i = 0; i < 8; ++i) {
        const int item = tid + 512 * i, hv = item >> 10, row = (item >> 4) & 63, ch = item & 15;
        *(uint4*)(smem + C3_V + hv * 64 * ROWB + row * ROWB + ch * 16) = *(const uint4*)(P + (size_t)(tc + row) * PLD + C_CV + hv * 128 + ch * 8);
    }
    float* tb = (float*)(smem + C3_TB) + wave * 192; float* tu = tb + 64; float* tcm = tb + 128;
    const float mprev = MP[h * NCH + c];
    {
        const float fpre = SM[(size_t)(tc + lane) * 16 + 8 + h], ipre = SM[(size_t)(tc + lane) * 16 + 4 + h];
        const float bcum = scan_sum64(logsigmoidf(fpre), lane);
        const float u = ipre - bcum;
        const float cm = fmaxf(scan_max64(u, lane), mprev);
        tb[lane] = bcum; tu[lane] = u; tcm[lane] = cm;
    }
    __syncthreads();
    const int lq = qh * 32 + q;
    const float cmq = tcm[lq], bq_ = tb[lq];
    const u16* QC = (const u16*)(ws_ + OFF_MG) + (size_t)(tc + lq) * 512 + h * 128 + hh * 8;
    const u16* KC = (const u16*)(ws_ + OFF_MG) + (size_t)SEQ * 512 + (size_t)(tc + q) * 512 + h * 128 + hh * 8;
    f32x16 xacc[2];
#pragma unroll
    for (int i = 0; i < 2; ++i)
#pragma unroll
        for (int e = 0; e < 16; ++e) xacc[i][e] = 0.f;
#pragma unroll
    for (int ks = 0; ks < 8; ++ks) {
        const bf8 bqv = ld_bf8(QC + ks * 16);
#pragma unroll
        for (int mt = 0; mt < 2; ++mt) xacc[mt] = mfma32(ld_bf8(KC + (size_t)mt * 32 * 512 + ks * 16), bqv, xacc[mt]);
    }
#pragma unroll
    for (int mt = 0; mt < 2; ++mt)
#pragma unroll
        for (int reg = 0; reg < 16; ++reg) {
            const int s = mt * 32 + (reg & 3) + 8 * (reg >> 2) + 4 * hh;
            const float wgt = (s <= lq) ? __expf(tu[s] - cmq) : 0.f;
            xacc[mt][reg] *= wgt;
        }
    f32x16 num[5];
#pragma unroll
    for (int i = 0; i < 5; ++i)
#pragma unroll
        for (int e = 0; e < 16; ++e) num[i][e] = 0.f;
    const u16* ct = (const u16*)(ws_ + OFF_CTB) + ((size_t)(h * NCH + c) * 128) * 128;
    const float* nsv = NS + (size_t)(h * NCH + c) * 128;
#pragma unroll 4
    for (int ks = 0; ks < 8; ++ks) {
        const int d0 = ks * 16 + hh * 8;
        const bf8 bqv = ld_bf8(QC + ks * 16);
#pragma unroll
        for (int emt = 0; emt < 4; ++emt) {
            const bf8 af = ld_bf8(ct + (size_t)(emt * 32 + q) * 128 + d0);
            num[emt] = mfma32(af, bqv, num[emt]);
        }
        float4 n0 = make_float4(0.f, 0.f, 0.f, 0.f), n1 = n0;
        if (q == 0) { n0 = *(const float4*)(nsv + d0); n1 = *(const float4*)(nsv + d0 + 4); }
        const bf8 an = pack8(n0.x, n0.y, n0.z, n0.w, n1.x, n1.y, n1.z, n1.w);
        num[4] = mfma32(an, bqv, num[4]);
    }
    const float isc = __expf(mprev - cmq);
#pragma unroll
    for (int i = 0; i < 5; ++i)
#pragma unroll
        for (int e = 0; e < 16; ++e) num[i][e] *= isc;
    const int g16 = lane >> 4, i16 = lane & 15, qrow = i16 >> 2, pp = i16 & 3, hp = g16 >> 1;
    const unsigned char* vb = smem + C3_V + h * 64 * ROWB;
    const bf8 ones = pack8(1.f, 1.f, 1.f, 1.f, 1.f, 1.f, 1.f, 1.f), zeros = pack8(0.f, 0.f, 0.f, 0.f, 0.f, 0.f, 0.f, 0.f);
    const bf8 aext = (q == 0) ? ones : zeros;
#pragma unroll
    for (int mt = 0; mt < 2; ++mt)
#pragma unroll
        for (int sp = 0; sp < 2; ++sp) {
            const bf8 bp = pack8(xacc[mt][8 * sp + 0], xacc[mt][8 * sp + 1], xacc[mt][8 * sp + 2], xacc[mt][8 * sp + 3],
                                 xacc[mt][8 * sp + 4], xacc[mt][8 * sp + 5], xacc[mt][8 * sp + 6], xacc[mt][8 * sp + 7]);
            const int rb = mt * 32 + 16 * sp + 4 * hp + qrow;
#pragma unroll
            for (int emt = 0; emt < 4; ++emt) {
                const unsigned char* a0 = vb + rb * ROWB + (32 * emt + 16 * (g16 & 1) + 4 * pp) * 2;
                const bf8 af = tr_pair(a0, a0 + 8 * ROWB);
                num[emt] = mfma32(af, bp, num[emt]);
            }
            num[4] = mfma32(aext, bp, num[4]);
            __builtin_amdgcn_sched_barrier(0);
        }
    const float den = __shfl(num[4][0], q);
    const float mrow = bq_ + cmq;
    const float dn = fmaxf(fabsf(den), __expf(-mrow));
    const float rdn = 1.f / dn;
    const size_t t = (size_t)(tc + lq);
    float s1 = 0.f, s2 = 0.f;
#pragma unroll
    for (int emt = 0; emt < 4; ++emt)
#pragma unroll
        for (int rg = 0; rg < 4; ++rg) {
            const int e0 = emt * 32 + 8 * rg + 4 * hh;
            const uint2 oz = *(const uint2*)(P + t * PLD + C_CO + h * 128 + e0);
            const float v0 = num[emt][4 * rg + 0] * rdn * sigmoidf(bflo(oz.x));
            const float v1 = num[emt][4 * rg + 1] * rdn * sigmoidf(bfhi(oz.x));
            const float v2 = num[emt][4 * rg + 2] * rdn * sigmoidf(bflo(oz.y));
            const float v3 = num[emt][4 * rg + 3] * rdn * sigmoidf(bfhi(oz.y));
            num[emt][4 * rg + 0] = v0; num[emt][4 * rg + 1] = v1; num[emt][4 * rg + 2] = v2; num[emt][4 * rg + 3] = v3;
            s1 += v0 + v1 + v2 + v3; s2 += v0 * v0 + v1 * v1 + v2 * v2 + v3 * v3;
            __builtin_amdgcn_sched_barrier(0);
        }
    s1 += __shfl_xor(s1, 32); s2 += __shfl_xor(s2, 32);
    const float mu = s1 * (1.f / 128.f);
    const float var = fmaxf(s2 * (1.f / 128.f) - mu * mu, 0.f);
    const float rs = rsqrtf(var + 1e-6f);
    const float* cnw = p.c_norm_w + l * 512 + h * 128;
#pragma unroll
    for (int emt = 0; emt < 4; ++emt)
#pragma unroll
        for (int rg = 0; rg < 4; ++rg) {
            const int e0 = emt * 32 + 8 * rg + 4 * hh;
            const uint2 zz = *(const uint2*)(P + t * PLD + C_CZ + h * 128 + e0);
            const float4 nw = *(const float4*)(cnw + e0);
            const float y0 = (num[emt][4 * rg + 0] - mu) * rs * nw.x * siluf(bflo(zz.x));
            const float y1 = (num[emt][4 * rg + 1] - mu) * rs * nw.y * siluf(bfhi(zz.x));
            const float y2 = (num[emt][4 * rg + 2] - mu) * rs * nw.z * siluf(bflo(zz.y));
            const float y3 = (num[emt][4 * rg + 3] - mu) * rs * nw.w * siluf(bfhi(zz.y));
            *(uint2*)(YBR + t * 1536 + 1024 + h * 128 + e0) = make_uint2(pk2(y0, y1), pk2(y2, y3));
            __builtin_amdgcn_sched_barrier(0);
        }
    __syncthreads();
}

__global__ void __launch_bounds__(512) mega(Params p) {
    extern __shared__ __attribute__((aligned(16))) unsigned char smem[];
    cg::grid_group grid = cg::this_grid();
    if (blockIdx.x == 0) { for (int i = threadIdx.x; i < (int)(CTL_BYTES / 4); i += 512) ((u32*)(p.ws + OFF_CTL))[i] = 0; }
    volatile LAS unsigned* xst = (volatile LAS unsigned*)(smem + LDS_BYTES - 32);
    if (threadIdx.x == 0) { xst[0] = 0; xst[1] = 0; }
    phase_p0(p, smem);
    phase_px(p, p.x);
    grid.sync();
    const XcdBarrier xb = xcd_barrier_post((unsigned*)(p.ws + OFF_BAR), xst);
#pragma unroll 1
    for (int l = 0; l < 2; ++l) {
        if (l == 1) { phase_px(p, p.out); xcd_barrier(xb); }
#pragma unroll 1
        for (int b = 0; b < NBATCH; ++b) {
            for (int rep = 0; rep < DUP_G1; ++rep) phase_g1(p, l, b, smem);
            xcd_barrier(xb);
            {
                u32* qhead = (u32*)(p.ws + OFF_CTL) + (l * 2 + b) * 8;
                u32* qslot = (u32*)(smem + LDS_BYTES - 16);
#pragma unroll 1
                for (;;) {
                    __syncthreads();
                    if (threadIdx.x == 0) *qslot = atomicAdd(qhead, 1u);
                    __syncthreads();
                    const int item = (int)*qslot;
                    if (item >= 1024) break;
                    if (item < 512) a_unit(p, 255 - (item >> 1), item & 1, smem);
                    else if (item < 768) { for (int rep = 0; rep < DUP_B; ++rep) b_unit(p, l, item - 512, smem); }
                    else { for (int rep = 0; rep < DUP_C1; ++rep) c1_unit(p, l, item - 768, smem); }
                }
            }
            xcd_barrier(xb);
            {
                u32* qheads = (u32*)(p.ws + OFF_CTL) + (l * 2 + b) * 8 + 1;
                u32* qslot = (u32*)(smem + LDS_BYTES - 16);
#pragma unroll 1
                for (;;) {
                    __syncthreads();
                    if (threadIdx.x == 0) *qslot = atomicAdd(qheads + 2, 1u);
                    __syncthreads();
                    const int item = (int)*qslot;
                    if (item >= 257) break;
                    m2_unit(p, item, smem);
                    asm volatile("s_waitcnt vmcnt(0)" ::: "memory");
                    __syncthreads();
                    if (threadIdx.x == 0) {
                        __builtin_amdgcn_fence(__ATOMIC_RELEASE, "agent");
                        asm volatile("s_waitcnt vmcnt(0)" ::: "memory");
                        __hip_atomic_fetch_add(qheads + 3, 1u, __ATOMIC_RELAXED, __HIP_MEMORY_SCOPE_AGENT);
                    }
                }
                const int g0 = (int)(xb.x & 1u);
                int natt = 0; bool c3_done = false;
#pragma unroll 1
                for (int pass = 0; pass < 2; ++pass) {
                    const int g = g0 ^ pass;
#pragma unroll 1
                    for (;;) {
                        if (!c3_done && (natt >= 2 || pass == 1)) {
                            bool acquired = false;
#pragma unroll 1
                            for (;;) {
                                __syncthreads();
                                if (threadIdx.x == 0) *qslot = atomicAdd(qheads + 4, 1u);
                                __syncthreads();
                                const int citem = (int)*qslot;
                                if (citem >= 256) break;
                                if (!acquired) {
                                    if (threadIdx.x == 0) {
                                        unsigned spins = 0;
                                        while (__hip_atomic_load(qheads + 3, __ATOMIC_RELAXED, __HIP_MEMORY_SCOPE_AGENT) < 257u) { __builtin_amdgcn_s_sleep(2); if (++spins > (1u << 24)) break; }
                                        __builtin_amdgcn_fence(__ATOMIC_ACQUIRE, "agent");
                                        asm volatile("s_waitcnt vmcnt(0)" ::: "memory");
                                    }
                                    __syncthreads();
                                    acquired = true;
                                }
                                for (int rep = 0; rep < DUP_C3; ++rep) c3_unit(p, l, citem, smem);
                            }
                            c3_done = true;
                        }
                        __syncthreads();
                        if (threadIdx.x == 0) *qslot = atomicAdd(qheads + g, 1u);
                        __syncthreads();
                        const int item = (int)*qslot;
                        if (item >= 512) break;
                        att_unit(p, 255 - (item >> 1), item & 1, g, smem);
                        ++natt;
                    }
                }
            }
            xcd_barrier(xb);
            for (int rep = 0; rep < DUP_G2; ++rep) phase_g2(p, l, b, smem);
            xcd_barrier(xb);
            phase_g3(p, l, b, smem);
            xcd_barrier(xb);
        }
    }
    phase_pf(p);
}

extern "C" void kernel_launch(void* const* d_in, const int* in_sizes, int n_in, void* d_out, int out_size, void* d_ws, size_t ws_size, hipStream_t stream) {
    static int grid_blocks = 0;
    if (!grid_blocks) {
        int dev = 0, cus = 0, per_cu = 0;
        hipGetDevice(&dev);
        hipDeviceGetAttribute(&cus, hipDeviceAttributeMultiprocessorCount, dev);
        hipFuncSetAttribute((const void*)mega, hipFuncAttributeMaxDynamicSharedMemorySize, LDS_BYTES);
        hipOccupancyMaxActiveBlocksPerMultiprocessor(&per_cu, mega, 512, LDS_BYTES);
        if (per_cu < 1) { fprintf(stderr, "occupancy query says 0 blocks/CU\n"); per_cu = 1; }
        grid_blocks = cus;
        if (ws_size < WS_NEED) fprintf(stderr, "workspace too small: %zu < %zu\n", ws_size, (size_t)WS_END);
    }
    Params p{};
    p.x = (const float*)d_in[0]; p.norm_g = (const float*)d_in[1]; p.w_in = (const float*)d_in[2]; p.b_in = (const float*)d_in[3];
    p.f_bias = (const float*)d_in[4]; p.conv_w = (const float*)d_in[5]; p.conv_b = (const float*)d_in[6]; p.rel_bias = (const float*)d_in[7];
    p.c_norm_w = (const float*)d_in[8]; p.w_branch = (const float*)d_in[9]; p.w_out = (const float*)d_in[10]; p.final_g = (const float*)d_in[11];
    p.out = (float*)d_out; p.ws = (unsigned char*)d_ws;
    void* args[] = {&p};
    hipError_t e = hipLaunchCooperativeKernel((void*)mega, dim3(grid_blocks), dim3(512), args, LDS_BYTES, stream);
    if (e != hipSuccess) fprintf(stderr, "cooperative launch failed: %s (grid %d)\n", hipGetErrorString(e), grid_blocks);
}
```

```cpp
#include <hip/hip_runtime.h>
#include <hip/hip_cooperative_groups.h>
#include <cstdio>
namespace cg = cooperative_groups;
#ifndef DUP_G1
#define DUP_G1 1
#endif
#ifndef DUP_ASEL
#define DUP_ASEL 1
#endif
#ifndef DUP_AATT
#define DUP_AATT 1
#endif
#ifndef DUP_B
#define DUP_B 1
#endif
#ifndef DUP_C1
#define DUP_C1 1
#endif
#ifndef DUP_C3
#define DUP_C3 1
#endif
#ifndef DUP_G2
#define DUP_G2 1
#endif

typedef __bf16 bf8 __attribute__((ext_vector_type(8)));
typedef float f32x16 __attribute__((ext_vector_type(16)));
typedef float f32x4 __attribute__((ext_vector_type(4)));
typedef float f32x2 __attribute__((ext_vector_type(2)));
typedef short s16x4 __attribute__((ext_vector_type(4)));
typedef unsigned short u16;
typedef unsigned int u32;
typedef unsigned long long u64;

constexpr int SEQ = 16384, NBATCH = 2, T_TOK = 32768, DM = 1024, NCH = 256;
constexpr int INW = 9292;
constexpr int C_AQ = 0, C_AK = 512, C_IQ = 768, C_IK = 1024, C_AZ = 1088, C_BQ = 1600, C_BK = 2112, C_BV = 2624, C_BZ = 3136,
              C_CQ = 3648, C_CK = 4160, C_CV = 4672, C_CO = 5184, C_CZ = 5696, C_SM = 6208, N1 = 6272, PLD = 6208;
constexpr int LDS_BYTES = 160 * 1024;

constexpr size_t al(size_t x) { return (x + 255) & ~(size_t)255; }
constexpr size_t OFF_CS = 0;
constexpr size_t OFF_WT1 = al(OFF_CS + (size_t)SEQ * 8 * 8);
constexpr size_t OFF_WG = al(OFF_WT1 + (size_t)2 * N1 * 1024 * 2);
constexpr size_t OFF_WB = al(OFF_WG + (size_t)2 * 3072 * 1024 * 2);
constexpr size_t OFF_WO = al(OFF_WB + (size_t)2 * 3 * 1024 * 512 * 2);
constexpr size_t OFF_B1 = al(OFF_WO + (size_t)2 * 1024 * 1024 * 2);
constexpr size_t OFF_BG = al(OFF_B1 + (size_t)2 * N1 * 4);
constexpr size_t OFF_XB = al(OFF_BG + (size_t)2 * 3072 * 4);
constexpr size_t OFF_R = al(OFF_XB + (size_t)T_TOK * 1024 * 2);
constexpr size_t OFF_P = al(OFF_R + (size_t)T_TOK * 4);
constexpr size_t OFF_KVA = al(OFF_P + (size_t)SEQ * PLD * 2);
constexpr size_t OFF_IK = al(OFF_KVA + (size_t)SEQ * 256 * 2);
constexpr size_t OFF_SM = al(OFF_IK + (size_t)SEQ * 64 * 2);
constexpr size_t OFF_YBR = al(OFF_SM + (size_t)SEQ * 16 * 4);
constexpr size_t OFF_KVS = al(OFF_YBR + (size_t)SEQ * 1536 * 2);
constexpr size_t OFF_NS = al(OFF_KVS + (size_t)4 * NCH * 128 * 128 * 4);
constexpr size_t OFF_GC = al(OFF_NS + (size_t)4 * NCH * 128 * 4);
constexpr size_t OFF_ML = al(OFF_GC + (size_t)4 * NCH * 4);
constexpr size_t OFF_MP = al(OFF_ML + (size_t)4 * NCH * 4);
constexpr size_t OFF_MG = al(OFF_MP + (size_t)4 * NCH * 4);
constexpr size_t WS_END = al(OFF_MG + (size_t)SEQ * 1024 * 2);
constexpr size_t OFF_CTL = WS_END;
constexpr size_t OFF_BAR = OFF_CTL + 1024;
constexpr size_t CTL_BYTES = 1024 + 3456 * 4;
constexpr size_t OFF_SEL = al(OFF_CTL + CTL_BYTES);
constexpr size_t OFF_CTB = al(OFF_SEL + (size_t)SEQ * 256 * 2);
constexpr size_t WS_NEED = OFF_CTB + (size_t)4 * NCH * 128 * 128 * 2;
static_assert(WS_NEED <= (size_t)512 * 1024 * 1024, "workspace too large");

struct Params {
    const float *x, *norm_g, *w_in, *b_in, *f_bias, *conv_w, *conv_b, *rel_bias, *c_norm_w, *w_branch, *w_out, *final_g;
    float* out; unsigned char* ws;
};

__device__ __forceinline__ int opaque_tid() { int t = threadIdx.x; asm volatile("" : "+v"(t)); return t; }
__device__ __forceinline__ unsigned char* opaque_ptr(unsigned char* p) { unsigned z = 0; asm volatile("" : "+s"(z)); return p + z; }
__device__ __forceinline__ u32 pk2(float a, float b) {
    __bf16 x = (__bf16)a, y = (__bf16)b;
    return (u32)__builtin_bit_cast(u16, x) | ((u32)__builtin_bit_cast(u16, y) << 16);
}
__device__ __forceinline__ u16 f2bf(float a) { __bf16 x = (__bf16)a; return __builtin_bit_cast(u16, x); }
__device__ __forceinline__ float bf2f(u16 v) { return __uint_as_float((u32)v << 16); }
__device__ __forceinline__ float bflo(u32 v) { return __uint_as_float(v << 16); }
__device__ __forceinline__ float bfhi(u32 v) { return __uint_as_float(v & 0xffff0000u); }
__device__ __forceinline__ bf8 ld_bf8(const void* p) { return *(const bf8*)p; }
__device__ __forceinline__ bf8 u4_to_bf8(uint4 u) { return __builtin_bit_cast(bf8, u); }
__device__ __forceinline__ f32x16 mfma32(bf8 a, bf8 b, f32x16 c) { return __builtin_amdgcn_mfma_f32_32x32x16_bf16(a, b, c, 0, 0, 0); }
__device__ __forceinline__ f32x4 mfma16(bf8 a, bf8 b, f32x4 c) { return __builtin_amdgcn_mfma_f32_16x16x32_bf16(a, b, c, 0, 0, 0); }
template <int CTRL, int RMASK> __device__ __forceinline__ float dppf(float old, float v) {
    return __int_as_float(__builtin_amdgcn_update_dpp(__float_as_int(old), __float_as_int(v), CTRL, RMASK, 0xF, false));
}
template <int CTRL, int RMASK> __device__ __forceinline__ u32 dppu(u32 old, u32 v) { return (u32)__builtin_amdgcn_update_dpp((int)old, (int)v, CTRL, RMASK, 0xF, false); }
__device__ __forceinline__ u32 scan_add_u32(u32 v) {
    v += dppu<0x111, 0xF>(0u, v); v += dppu<0x112, 0xF>(0u, v); v += dppu<0x114, 0xF>(0u, v); v += dppu<0x118, 0xF>(0u, v);
    v += dppu<0x142, 0xA>(0u, v); v += dppu<0x143, 0xC>(0u, v);
    return v;
}
__device__ __forceinline__ float wave_sum(float v) {
    v += dppf<0xB1, 0xF>(0.f, v); v += dppf<0x4E, 0xF>(0.f, v); v += dppf<0x141, 0xF>(0.f, v); v += dppf<0x140, 0xF>(0.f, v);
    v += dppf<0x142, 0xA>(0.f, v); v += dppf<0x143, 0xC>(0.f, v);
    return __int_as_float(__builtin_amdgcn_readlane(__float_as_int(v), 63));
}
__device__ __forceinline__ float wave_max(float v) {
    v = fmaxf(v, dppf<0xB1, 0xF>(v, v)); v = fmaxf(v, dppf<0x4E, 0xF>(v, v)); v = fmaxf(v, dppf<0x141, 0xF>(v, v)); v = fmaxf(v, dppf<0x140, 0xF>(v, v));
    v = fmaxf(v, dppf<0x142, 0xA>(v, v)); v = fmaxf(v, dppf<0x143, 0xC>(v, v));
    return __int_as_float(__builtin_amdgcn_readlane(__float_as_int(v), 63));
}
__device__ __forceinline__ float relu_i(float x) { const int b = __float_as_int(x); return __int_as_float(b > 0 ? b : 0); }
__device__ __forceinline__ int cvt_flr(float x) { int r; asm("v_cvt_flr_i32_f32 %0, %1" : "=v"(r) : "v"(x)); return r; }
__device__ __forceinline__ void count_zero(u32& n, float v) { asm("v_cmp_eq_f32 vcc, 0, %1\n\tv_addc_co_u32 %0, vcc, 0, %0, vcc" : "+v"(n) : "v"(v) : "vcc"); }
__device__ __forceinline__ float fma_s(float a, float b, float c) { float d; asm("v_fma_f32 %0, %1, %2, %3" : "=v"(d) : "v"(a), "v"(b), "v"(c)); return d; }
template <int N> struct IC { static constexpr int value = N; };
__device__ __forceinline__ void shift_in_ge(u32& mask, float v, float thr) {
    asm("v_cmp_ge_f32 vcc, %1, %2\n\tv_addc_co_u32 %0, vcc, %0, %0, vcc" : "+v"(mask) : "v"(v), "v"(thr) : "vcc");
}
__device__ __forceinline__ float pick16(const f32x16& sc, int reg) {
    const bool b0 = reg & 1, b1 = reg & 2, b2 = reg & 4, b3 = reg & 8;
    const float a0 = b0 ? sc[1] : sc[0], a1 = b0 ? sc[3] : sc[2], a2 = b0 ? sc[5] : sc[4], a3 = b0 ? sc[7] : sc[6];
    const float a4 = b0 ? sc[9] : sc[8], a5 = b0 ? sc[11] : sc[10], a6 = b0 ? sc[13] : sc[12], a7 = b0 ? sc[15] : sc[14];
    const float c0 = b1 ? a1 : a0, c1 = b1 ? a3 : a2, c2 = b1 ? a5 : a4, c3 = b1 ? a7 : a6;
    const float d0 = b2 ? c1 : c0, d1 = b2 ? c3 : c2;
    return b3 ? d1 : d0;
}
__device__ __forceinline__ float sigmoidf(float x) { return __builtin_amdgcn_rcpf(1.f + __expf(-x)); }
__device__ __forceinline__ float siluf(float x) { return x * __builtin_amdgcn_rcpf(1.f + __expf(-x)); }
__device__ __forceinline__ float logsigmoidf(float x) { return fminf(x, 0.f) - log1pf(__expf(-fabsf(x))); }
__device__ __forceinline__ s16x4 ds_tr(const void* p) {
    return __builtin_amdgcn_ds_read_tr16_b64_v4i16((s16x4 __attribute__((address_space(3)))*)(p));
}
__device__ __forceinline__ bf8 tr_pair(const unsigned char* p0, const unsigned char* p1) {
    s16x4 lo = ds_tr(p0), hi = ds_tr(p1);
    typedef short s16x8 __attribute__((ext_vector_type(8)));
    s16x8 r = {lo[0], lo[1], lo[2], lo[3], hi[0], hi[1], hi[2], hi[3]};
    return __builtin_bit_cast(bf8, r);
}
__device__ __forceinline__ bf8 pack8(float a, float b, float c, float d, float e, float f, float g, float h) {
    uint4 u; u.x = pk2(a, b); u.y = pk2(c, d); u.z = pk2(e, f); u.w = pk2(g, h);
    return __builtin_bit_cast(bf8, u);
}


#define XB_TMO      128
#define XB_XCNT(j)  (256  + 64 * (j))
#define XB_XSUB(j)  (1280 + 64 * (j))
#define XB_XGEN(j)  (2304 + 64 * (j))
#define XB_TOP      3328
#define XB_TOPGEN   3392
#define XCD_BAR_WORDS 3456
#define XB_SPIN_CAP (1u << 22)
#define LAS __attribute__((address_space(3)))
__device__ __forceinline__ unsigned xb_ld(unsigned* p)              { return __hip_atomic_load(p, __ATOMIC_RELAXED, __HIP_MEMORY_SCOPE_AGENT); }
__device__ __forceinline__ unsigned xb_add(unsigned* p, unsigned v) { return __hip_atomic_fetch_add(p, v, __ATOMIC_RELAXED, __HIP_MEMORY_SCOPE_AGENT); }
__device__ __forceinline__ unsigned xb_xcc_id() { return (unsigned)__builtin_amdgcn_s_getreg((3 << 11) | 20) & 0xFu; }
#define XB_SPIN(cond, bar) do { unsigned _sp = 0; while (cond) { __builtin_amdgcn_s_sleep(1); \
    if ((++_sp & 255u) == 0u) { if (xb_ld(&(bar)[XB_TMO])) break; if (_sp > XB_SPIN_CAP) { atomicAdd(&(bar)[XB_TMO], 1u); break; } } } } while (0)
struct XcdBarrier { unsigned* bar; unsigned x; volatile LAS unsigned* st; };
__device__ __forceinline__ XcdBarrier xcd_barrier_post(unsigned* bar, volatile LAS unsigned* st) {
    XcdBarrier b; b.bar = bar; b.x = xb_xcc_id(); b.st = st;
    if (threadIdx.x == 0) (void)xb_add(&bar[XB_XCNT(b.x)], 1u);
    return b;
}
__device__ __forceinline__ void xcd_barrier_complete(unsigned* bar, unsigned x, unsigned& nloc, unsigned& nx) {
    const unsigned G = gridDim.x * gridDim.y * gridDim.z;
    unsigned sum, cnt, mine, sp = 0u;
    for (;;) {
        sum = 0u; cnt = 0u; mine = 0u;
#pragma unroll
        for (unsigned j = 0; j < 16; ++j) { const unsigned c = xb_ld(&bar[XB_XCNT(j)]); sum += c; cnt += (c > 0u) ? 1u : 0u; mine = (j == x) ? c : mine; }
        if (sum == G) break;
        __builtin_amdgcn_s_sleep(1);
        if ((++sp & 255u) == 0u) { if (xb_ld(&bar[XB_TMO])) break; if (sp > XB_SPIN_CAP) { atomicAdd(&bar[XB_TMO], 1u); break; } }
    }
    nloc = mine > 0u ? mine : 1u; nx = cnt > 0u ? cnt : 1u;
}
__device__ __forceinline__ void xcd_barrier(const XcdBarrier& b) {
    asm volatile("s_waitcnt vmcnt(0)" ::: "memory");
    __syncthreads();
    if (threadIdx.x == 0) {
        unsigned* bar = b.bar;
        __builtin_amdgcn_s_waitcnt(0);
        unsigned nloc = b.st[0], nx = b.st[1];
        if (nloc == 0u) { xcd_barrier_complete(bar, b.x, nloc, nx); b.st[0] = nloc; b.st[1] = nx; }
        const unsigned old = xb_add(&bar[XB_XSUB(b.x)], 1u);
        const unsigned gen = old / nloc;
        if (old + 1u == (gen + 1u) * nloc) {
            __builtin_amdgcn_fence(__ATOMIC_RELEASE, "agent");
            asm volatile("s_waitcnt vmcnt(0)" ::: "memory");
            const unsigned og = xb_add(&bar[XB_TOP], 1u);
            const unsigned tg = og / nx;
            if (og + 1u == (tg + 1u) * nx) xb_add(&bar[XB_TOPGEN], 1u);
            else XB_SPIN(xb_ld(&bar[XB_TOPGEN]) == tg, bar);
            __builtin_amdgcn_fence(__ATOMIC_ACQUIRE, "agent");
            xb_add(&bar[XB_XGEN(b.x)], 1u);
            asm volatile("s_waitcnt vmcnt(0)" ::: "memory");
        } else {
            XB_SPIN(xb_ld(&bar[XB_XGEN(b.x)]) == gen, bar);
            __builtin_amdgcn_fence(__ATOMIC_ACQUIRE, "agent");
            asm volatile("s_waitcnt vmcnt(0)" ::: "memory");
        }
    }
    __syncthreads();
}

__device__ __forceinline__ int colmap1(int n) {
    if (n < 1088) return n;
    if (n < 5184) return n + 4;
    if (n < 6208) return n + 12;
    if (n < 6212) return 1088 + (n - 6208);
    if (n < 6216) return 5188 + (n - 6212);
    if (n < 6220) return 5192 + (n - 6216);
    return -1;
}
__device__ __forceinline__ void tr_item(const float* __restrict__ src, int ld, int kind, const float* __restrict__ gk, u16* __restrict__ dst,
                                        int K, int k0, int n0, int nlim, float* tile) {
    const int tid = opaque_tid();
    const int n4 = (tid & 63) * 4, kk0 = tid >> 6;
    int sc = n0 + n4;
    if (sc >= nlim) sc = -1; else if (kind == 0) sc = colmap1(sc); else if (kind == 1) sc = 6220 + sc;
    float4 v[8];
#pragma unroll
    for (int j = 0; j < 8; ++j) {
        const int kk = kk0 + 8 * j; v[j] = make_float4(0.f, 0.f, 0.f, 0.f);
        if (sc >= 0) v[j] = *(const float4*)(src + (size_t)(k0 + kk) * ld + sc);
    }
#pragma unroll
    for (int j = 0; j < 8; ++j) {
        const int kk = kk0 + 8 * j;
        const float gm = gk ? gk[k0 + kk] : 1.f;
        float* tp = tile + kk * 257 + n4;
        tp[0] = v[j].x * gm; tp[1] = v[j].y * gm; tp[2] = v[j].z * gm; tp[3] = v[j].w * gm;
    }
    __syncthreads();
    const int kg = tid & 7;
#pragma unroll
    for (int ps = 0; ps < 4; ++ps) {
        const int n = (tid >> 3) + 64 * ps;
        if (n0 + n < nlim) {
            float f[8];
#pragma unroll
            for (int j = 0; j < 8; ++j) f[j] = tile[(kg * 8 + j) * 257 + n];
            uint4 o; o.x = pk2(f[0], f[1]); o.y = pk2(f[2], f[3]); o.z = pk2(f[4], f[5]); o.w = pk2(f[6], f[7]);
            *(uint4*)(dst + (size_t)(n0 + n) * K + k0 + kg * 8) = o;
        }
    }
    __syncthreads();
}
__device__ __forceinline__ void sincos_tab(double a, float& s, float& c) {
    const double k = rint(a * 0.63661977236758134308);
    double r = fma(-k, 1.57079632679489655800e+00, a); r = fma(-k, 6.12323399573676603587e-17, r);
    const int qd = (int)((long long)k & 3);
    const double r2 = r * r;
    const double sp = r * (1.0 + r2 * (-1.0 / 6 + r2 * (1.0 / 120 + r2 * (-1.0 / 5040 + r2 * (1.0 / 362880 + r2 * (-1.0 / 39916800 + r2 * (1.0 / 6227020800.0)))))));
    const double cp = 1.0 + r2 * (-0.5 + r2 * (1.0 / 24 + r2 * (-1.0 / 720 + r2 * (1.0 / 40320 + r2 * (-1.0 / 3628800 + r2 * (1.0 / 479001600.0 + r2 * (-1.0 / 87178291200.0)))))));
    float sv, cv;
    if (qd == 0) { sv = (float)sp; cv = (float)cp; } else if (qd == 1) { sv = (float)cp; cv = (float)-sp; }
    else if (qd == 2) { sv = (float)-sp; cv = (float)-cp; } else { sv = (float)-cp; cv = (float)sp; }
    s = sv; c = cv;
}
__device__ __forceinline__ void phase_p0(const Params& p, unsigned char* smem) {
    unsigned char* ws_ = opaque_ptr(p.ws);
    float* tile = (float*)smem;
    u16* WT1 = (u16*)(ws_ + OFF_WT1); u16* WG = (u16*)(ws_ + OFF_WG); u16* WB = (u16*)(ws_ + OFF_WB); u16* WO = (u16*)(ws_ + OFF_WO);
    constexpr int I1 = 25 * 16, I2 = 12 * 16, I3 = 3 * 4 * 8, I4 = 4 * 16, IL = I1 + I2 + I3 + I4;
    for (int it = blockIdx.x; it < 2 * IL; it += gridDim.x) {
        const int l = it / IL; int r = it % IL;
        const float* g = p.norm_g + l * 1024;
        if (r < I1) { tr_item(p.w_in + (size_t)l * 1024 * INW, INW, 0, g, WT1 + (size_t)l * N1 * 1024, 1024, (r & 15) * 64, (r >> 4) * 256, N1, tile); continue; } r -= I1;
        if (r < I2) { tr_item(p.w_in + (size_t)l * 1024 * INW, INW, 1, g, WG + (size_t)l * 3072 * 1024, 1024, (r & 15) * 64, (r >> 4) * 256, 3072, tile); continue; } r -= I2;
        if (r < I3) { const int nb = r / 32, rr = r % 32;
            tr_item(p.w_branch + ((size_t)(l * 3 + nb)) * 512 * 1024, 1024, 2, nullptr, WB + ((size_t)(l * 3 + nb)) * 1024 * 512, 512, (rr & 7) * 64, (rr >> 3) * 256, 1024, tile); continue; } r -= I3;
        tr_item(p.w_out + (size_t)l * 1024 * 1024, 1024, 2, nullptr, WO + (size_t)l * 1024 * 1024, 1024, (r & 15) * 64, (r >> 4) * 256, 1024, tile);
    }
    const int gt = blockIdx.x * 512 + opaque_tid(), ngt = gridDim.x * 512;
    float* B1 = (float*)(ws_ + OFF_B1); float* BG = (float*)(ws_ + OFF_BG);
    for (int i = gt; i < 2 * N1; i += ngt) { const int l = i / N1, n = i % N1; const int sc = colmap1(n);
        float v = sc >= 0 ? p.b_in[l * INW + sc] : 0.f; if (n >= 6216 && n < 6220) v += p.f_bias[l * 4 + (n - 6216)]; B1[i] = v; }
    for (int i = gt; i < 2 * 3072; i += ngt) { const int l = i / 3072, n = i % 3072; BG[i] = p.b_in[l * INW + 6220 + n]; }
    float2* CS = (float2*)(ws_ + OFF_CS);
    for (int i = gt; i < SEQ * 8; i += ngt) {
        const int pos = i >> 3, fi = i & 7;
        const float invf = 1.0f / powf(500000.0f, (float)fi * 2.0f / 16.0f);
        const float ang = (float)pos * invf;
        float s, c; sincos_tab((double)ang, s, c);
        CS[i] = make_float2(c, s);
    }
}
__device__ __forceinline__ void phase_px(const Params& p, const float* xsrc) {
    unsigned char* ws_ = opaque_ptr(p.ws);
    const int tid0 = opaque_tid(), lane = tid0 & 63, wave = tid0 >> 6;
    u16* XB = (u16*)(ws_ + OFF_XB);
    for (int row = blockIdx.x * 8 + wave; row < T_TOK; row += gridDim.x * 8) {
        const float4* xr = (const float4*)(xsrc + (size_t)row * DM);
        float4 v[4]; float s = 0.f;
#pragma unroll
        for (int j = 0; j < 4; ++j) { v[j] = xr[lane + 64 * j]; s += v[j].x * v[j].x + v[j].y * v[j].y + v[j].z * v[j].z + v[j].w * v[j].w; }
        s = wave_sum(s);
        const float r = rsqrtf(s * (1.f / DM) + 1e-6f);
        uint2* o = (uint2*)(XB + (size_t)row * DM);
#pragma unroll
        for (int j = 0; j < 4; ++j) o[lane + 64 * j] = make_uint2(pk2(v[j].x * r, v[j].y * r), pk2(v[j].z * r, v[j].w * r));
    }
}
__device__ __forceinline__ void phase_pf(const Params& p) {
    unsigned char* ws_ = opaque_ptr(p.ws);
    const int tid0 = opaque_tid(), lane = tid0 & 63, wave = tid0 >> 6;
    for (int row = blockIdx.x * 8 + wave; row < T_TOK; row += gridDim.x * 8) {
        float4* xr = (float4*)(p.out + (size_t)row * DM);
        float4 v[4]; float s = 0.f;
#pragma unroll
        for (int j = 0; j < 4; ++j) { v[j] = xr[lane + 64 * j]; s += v[j].x * v[j].x + v[j].y * v[j].y + v[j].z * v[j].z + v[j].w * v[j].w; }
        s = wave_sum(s);
        const float r = rsqrtf(s * (1.f / DM) + 1e-6f);
        const float4* g = (const float4*)p.final_g;
#pragma unroll
        for (int j = 0; j < 4; ++j) { const float4 gg = g[lane + 64 * j]; float4 w; w.x = v[j].x * r * gg.x; w.y = v[j].y * r * gg.y; w.z = v[j].z * r * gg.z; w.w = v[j].w * r * gg.w; xr[lane + 64 * j] = w; }
    }
}

template <int MT>
__device__ __forceinline__ void gemm_compute(f32x16 (&acc)[MT][2], const unsigned char* sA, const unsigned char* sB) {
#pragma unroll
    for (int ks = 0; ks < 4; ++ks) {
        bf8 a[MT], b[2];
#pragma unroll
        for (int mt = 0; mt < MT; ++mt) a[mt] = ld_bf8(sA + mt * 32 * 144 + ks * 32);
#pragma unroll
        for (int nt = 0; nt < 2; ++nt) b[nt] = ld_bf8(sB + nt * 32 * 144 + ks * 32);
#pragma unroll
        for (int mt = 0; mt < MT; ++mt)
#pragma unroll
            for (int nt = 0; nt < 2; ++nt) acc[mt][nt] = mfma32(a[mt], b[nt], acc[mt][nt]);
    }
}
#define GEMM_GLOAD(S, KT) do { const int kk_ = (KT) * 64; \
    S##a0 = *(const uint4*)(ga + kk_); S##a1 = *(const uint4*)(ga + (size_t)64 * lda + kk_); \
    if (MT == 2) { S##a2 = *(const uint4*)(ga + (size_t)128 * lda + kk_); S##a3 = *(const uint4*)(ga + (size_t)192 * lda + kk_); } \
    S##b0 = *(const uint4*)(gb + kk_); S##b1 = *(const uint4*)(gb + (size_t)64 * ldb + kk_); } while (0)
#define GEMM_LSTORE(S, ST) do { unsigned char* pa_ = smem + (ST) * STAGE + lrow * 144 + lch * 16; unsigned char* pb_ = pa_ + BM * 144; \
    *(uint4*)(pa_) = S##a0; *(uint4*)(pa_ + 64 * 144) = S##a1; \
    if (MT == 2) { *(uint4*)(pa_ + 128 * 144) = S##a2; *(uint4*)(pa_ + 192 * 144) = S##a3; } \
    *(uint4*)(pb_) = S##b0; *(uint4*)(pb_ + 64 * 144) = S##b1; } while (0)
#define GEMM_DECL(MT_) \
    constexpr int MT = MT_; constexpr int BM = MT * 128; constexpr int STAGE = (BM + 128) * 144; \
    uint4 r0a0, r0a1, r0a2 = make_uint4(0, 0, 0, 0), r0a3 = r0a2, r0b0, r0b1, r1a0, r1a1, r1a2 = r0a2, r1a3 = r0a2, r1b0, r1b1; \
    const int lrow = tid0 >> 3, lch = tid0 & 7; \
    const int fr = (lane & 31) * 144 + (lane >> 5) * 16; \
    const unsigned char* sA0 = smem + (wm * (MT * 32)) * 144 + fr; \
    const unsigned char* sB0 = smem + BM * 144 + (wn * 64) * 144 + fr; \
    const u16* ga = nullptr; const u16* gb = nullptr; int lda = 0, ldb = 0;
#define GEMM_ISSUE(A_, LDA_, B_, LDB_) do { lda = (LDA_); ldb = (LDB_); ga = (A_) + (size_t)lrow * lda + lch * 8; gb = (B_) + (size_t)lrow * ldb + lch * 8; \
    GEMM_GLOAD(r0, 0); GEMM_GLOAD(r1, 1); } while (0)
#define GEMM_RUN(K_, ACC) do { const int nk = (K_) >> 6; GEMM_LSTORE(r0, 0); __syncthreads(); \
    _Pragma("unroll 1") for (int kt = 0; kt < nk; kt += 2) { \
        GEMM_GLOAD(r0, kt + 2 < nk ? kt + 2 : kt); \
        gemm_compute<MT>(ACC, sA0, sB0); \
        GEMM_LSTORE(r1, 1); __syncthreads(); \
        GEMM_GLOAD(r1, kt + 3 < nk ? kt + 3 : kt + 1); \
        gemm_compute<MT>(ACC, sA0 + STAGE, sB0 + STAGE); \
        GEMM_LSTORE(r0, 0); __syncthreads(); } } while (0)

namespace pg8 {
#define PG8_LAS __attribute__((address_space(3)))
typedef unsigned short bf16_t;
typedef __bf16 mbf8 __attribute__((ext_vector_type(8)));
typedef float f32x4 __attribute__((ext_vector_type(4)));
typedef float f32x2 __attribute__((ext_vector_type(2)));
typedef unsigned u32x4 __attribute__((ext_vector_type(4)));
constexpr int BM = 256, BK = 64, HALF = 128, HTB = HALF * BK * 2, STAGE_BYTES = 8 * HTB, NXCD = 8, WGM = 8;
__host__ __device__ __forceinline__ int lds_byte(int r, int c) { const int st = (r >> 4) * 2 + (c >> 5), rr = r & 15, cc = c & 31, ob = rr * 64 + cc * 2; return st * 1024 + (ob ^ (((ob >> 9) & 1) << 5)); }
__host__ __device__ __forceinline__ void stage_rc(int b, int& R, int& C) { const int st = b / 1024, sb = b % 1024, swz = sb ^ (((sb >> 9) & 1) << 5); R = (st >> 1) * 16 + swz / 64; C = (st & 1) * 32 + (swz % 64) / 2; }
__host__ __device__ __forceinline__ int perm32(int rho) { const int n = rho >> 4, i = rho & 15; return 8 * (i >> 2) + 4 * n + (i & 3); }
struct Unit { int pm, pn, seg; };
struct Gemm { const bf16_t* A; const bf16_t* Bt; int lda, ldb, K; size_t segA, segB; };
struct StaticOrder {
    int nM, nN, nwg, G, c;
    __device__ void init(int M, int N, int G_, int c_) { nM = M / BM; nN = N / BM; nwg = nM * nN; G = G_; c = c_; }
    __device__ bool next(int i, Unit& u) const {
        const long L = (long)i * G + c; if (L >= nwg) return false;
        int wgid = (int)L; { const int q = nwg / NXCD, r = nwg % NXCD, xcd = wgid % NXCD, off = wgid / NXCD; wgid = (xcd < r ? xcd * (q + 1) : r * (q + 1) + (xcd - r) * q) + off; }
        const int nig = WGM * nN, gid = wgid / nig, fm = gid * WGM, gsz = (nM - fm) < WGM ? (nM - fm) : WGM;
        u.pm = fm + ((wgid % nig) % gsz); u.pn = (wgid % nig) / gsz; u.seg = 0; return true;
    }
};
template <class Epi, class Sched>
__device__ __forceinline__ void gemm_phase(PG8_LAS unsigned char* lds, const Gemm g, const Sched& S, const Epi& E) {
    const int tid = opaque_tid(), wid = __builtin_amdgcn_readfirstlane(tid >> 6), lane = tid & 63, wr = wid >> 2, wc = wid & 3, fr = lane & 15, fq = lane >> 4;
    const int nt = g.K / BK;
    unsigned voffA[2], voffB[2];
#pragma unroll
    for (int i = 0; i < 2; ++i) { int R, C; stage_rc(tid * 16 + i * 8192, R, C); const int Rb = Epi::PERM ? ((R & ~31) + perm32(R & 31)) : R;
        voffA[i] = (unsigned)(R * g.lda + C) * 2u; voffB[i] = (unsigned)(Rb * g.ldb + C) * 2u; }
    const size_t kstep = (size_t)(BK * 2);
    const size_t hstepA = (size_t)HALF * g.lda * 2, hstepB = (size_t)HALF * g.ldb * 2;
    const size_t tstepA = 2 * hstepA, tstepB = 2 * hstepB;
    const unsigned ldsw = (unsigned)wid * 1024u;
    const int aoff = lds_byte(wr * 64 + fr, fq * 8), boff = lds_byte(wc * 32 + fr, fq * 8);
#define PG8_SA(b, h) (((b) * 2 + (h)) * HTB)
#define PG8_SB(b, h) ((4 + (b) * 2 + (h)) * HTB)
#define PG8_STAGE(bufoff, gbase, voff) do { _Pragma("unroll") for (int _i = 0; _i < 2; ++_i) \
        __builtin_amdgcn_global_load_lds((const unsigned*)((const char*)(gbase) + (voff)[_i]), (PG8_LAS unsigned*)(lds + (bufoff) + ldsw + _i * 8192), 16, 0, 0); } while (0)
#define PG8_LDA(dst, b, h) do { _Pragma("unroll") for (int m = 0; m < 4; ++m) _Pragma("unroll") for (int k = 0; k < 2; ++k) dst[m][k] = *(const PG8_LAS mbf8*)(lds + PG8_SA(b, h) + aoff + m * 2048 + k * 1024); } while (0)
#define PG8_LDB(dst, b, h) do { _Pragma("unroll") for (int n = 0; n < 2; ++n) _Pragma("unroll") for (int k = 0; k < 2; ++k) dst[n][k] = *(const PG8_LAS mbf8*)(lds + PG8_SB(b, h) + boff + n * 2048 + k * 1024); } while (0)
#define PG8_MMA(ai, bj, At, Bt) do { __builtin_amdgcn_s_setprio(1); _Pragma("unroll") for (int m = 0; m < 4; ++m) _Pragma("unroll") for (int n = 0; n < 2; ++n) _Pragma("unroll") for (int k = 0; k < 2; ++k) \
        acc[ai][bj][m][n] = __builtin_amdgcn_mfma_f32_16x16x32_bf16(Bt[n][k], At[m][k], acc[ai][bj][m][n], 0, 0, 0); __builtin_amdgcn_s_setprio(0); } while (0)
#define PG8_WAIT_V(n) asm volatile("s_waitcnt vmcnt(" #n ")" ::: "memory")
#define PG8_WAIT_L(n) asm volatile("s_waitcnt lgkmcnt(" #n ")" ::: "memory")
#define PG8_BAR __builtin_amdgcn_s_barrier()
#define PG8_SCHED __builtin_amdgcn_sched_barrier(0)
    Unit cur, nxt; int ui = 0;
    if (!S.next(0, cur)) return;
    f32x4 acc[2][2][4][2];
#pragma unroll
    for (int a = 0; a < 2; ++a)
#pragma unroll
        for (int b = 0; b < 2; ++b)
#pragma unroll
            for (int m = 0; m < 4; ++m)
#pragma unroll
                for (int n = 0; n < 2; ++n) acc[a][b][m][n] = (f32x4){0.f, 0.f, 0.f, 0.f};
    mbf8 At[4][2], B0[2][2], B1[2][2];
    const char* cA = (const char*)g.A + (size_t)cur.seg * g.segA + (size_t)cur.pm * tstepA; const char* cB = (const char*)g.Bt + (size_t)cur.seg * g.segB + (size_t)cur.pn * tstepB;
    PG8_STAGE(PG8_SB(0, 0), cB, voffB); PG8_STAGE(PG8_SA(0, 0), cA, voffA); PG8_STAGE(PG8_SB(0, 1), cB + hstepB, voffB); PG8_STAGE(PG8_SA(0, 1), cA + hstepA, voffA);
    if (wr == 1) PG8_BAR;
    PG8_WAIT_V(4); PG8_BAR;
    PG8_STAGE(PG8_SB(1, 0), cB + kstep, voffB); PG8_STAGE(PG8_SA(1, 0), cA + kstep, voffA); PG8_STAGE(PG8_SB(1, 1), cB + hstepB + kstep, voffB);
    PG8_WAIT_V(6); PG8_BAR;
    for (;;) {
        const bool has_next = S.next(ui + 1, nxt);
        const char* nA = has_next ? (const char*)g.A + (size_t)nxt.seg * g.segA + (size_t)nxt.pm * tstepA : cA; const char* nB = has_next ? (const char*)g.Bt + (size_t)nxt.seg * g.segB + (size_t)nxt.pn * tstepB : cB;
        for (int t = 0; t < nt; t += 2) {
            const bool last = (t == nt - 2);
            const char* a1 = cA + (size_t)(t + 1) * kstep;
            const char* a2 = last ? nA : cA + (size_t)(t + 2) * kstep; const char* b2 = last ? nB : cB + (size_t)(t + 2) * kstep;
            const char* a3 = a2 + kstep; const char* b3 = b2 + kstep;
            PG8_LDB(B0, 0, 0); PG8_SCHED; PG8_LDA(At, 0, 0); PG8_STAGE(PG8_SA(1, 1), a1 + hstepA, voffA);
            PG8_WAIT_L(8); PG8_BAR; PG8_WAIT_L(0); PG8_MMA(0, 0, At, B0); PG8_BAR; PG8_SCHED;
            PG8_LDB(B1, 0, 1); PG8_STAGE(PG8_SB(0, 0), b2, voffB);
            PG8_BAR; PG8_WAIT_L(0); PG8_MMA(0, 1, At, B1); PG8_BAR;
            PG8_LDA(At, 0, 1); PG8_STAGE(PG8_SA(0, 0), a2, voffA);
            PG8_BAR; PG8_WAIT_L(0); PG8_MMA(1, 0, At, B0); PG8_BAR; PG8_SCHED;
            PG8_STAGE(PG8_SB(0, 1), b2 + hstepB, voffB);
            PG8_WAIT_V(6); PG8_BAR; PG8_MMA(1, 1, At, B1); PG8_BAR;
            PG8_LDB(B0, 1, 0); PG8_SCHED; PG8_LDA(At, 1, 0); PG8_STAGE(PG8_SA(0, 1), a2 + hstepA, voffA);
            PG8_WAIT_L(8); PG8_BAR; PG8_WAIT_L(0); PG8_MMA(0, 0, At, B0); PG8_BAR; PG8_SCHED;
            PG8_LDB(B1, 1, 1); PG8_STAGE(PG8_SB(1, 0), b3, voffB);
            PG8_BAR; PG8_WAIT_L(0); PG8_MMA(0, 1, At, B1); PG8_BAR;
            PG8_LDA(At, 1, 1); PG8_STAGE(PG8_SA(1, 0), a3, voffA);
            PG8_BAR; PG8_WAIT_L(0); PG8_MMA(1, 0, At, B0); PG8_BAR; PG8_SCHED;
            PG8_STAGE(PG8_SB(1, 1), b3 + hstepB, voffB);
            PG8_WAIT_V(6); PG8_BAR; PG8_MMA(1, 1, At, B1); PG8_BAR;
        }
        if (!(Epi::LATE && !has_next)) E(acc, cur, wr, wc, fr, fq);
        if (!has_next) break;
#pragma unroll
        for (int a = 0; a < 2; ++a)
#pragma unroll
            for (int b = 0; b < 2; ++b)
#pragma unroll
                for (int m = 0; m < 4; ++m)
#pragma unroll
                    for (int n = 0; n < 2; ++n) acc[a][b][m][n] = (f32x4){0.f, 0.f, 0.f, 0.f};
        cur = nxt; cA = nA; cB = nB; ++ui;
    }
    PG8_WAIT_V(0);
    if (wr == 0) PG8_BAR;
    PG8_BAR;
    if constexpr (Epi::LATE) E.late(acc, cur, lds, wid, lane, wr, wc, fr, fq);
#undef PG8_SA
#undef PG8_SB
#undef PG8_STAGE
#undef PG8_LDA
#undef PG8_LDB
#undef PG8_MMA
#undef PG8_WAIT_V
#undef PG8_WAIT_L
#undef PG8_BAR
#undef PG8_SCHED
}
struct EpiResid {
    static constexpr bool PERM = false, LATE = true;
    const float* xc; float* xo;
    __device__ __forceinline__ void operator()(const f32x4 (&acc)[2][2][4][2], const Unit& u, int wr, int wc, int fr, int fq) const {
        const int row0 = u.pm * BM + wr * 64 + fr, col0 = u.pn * BM + wc * 32 + 4 * fq;
#pragma unroll
        for (int ai = 0; ai < 2; ++ai)
#pragma unroll
            for (int m = 0; m < 4; ++m) {
                const size_t ro = (size_t)(row0 + ai * HALF + m * 16) * 1024 + col0;
#pragma unroll
                for (int bj = 0; bj < 2; ++bj)
#pragma unroll
                    for (int n = 0; n < 2; ++n) { const f32x4 xv = *(const f32x4*)(xc + ro + bj * HALF + n * 16); *(f32x4*)(xo + ro + bj * HALF + n * 16) = xv + acc[ai][bj][m][n]; }
            }
    }
    __device__ __forceinline__ void late(const f32x4 (&acc)[2][2][4][2], const Unit& u, PG8_LAS unsigned char* lds, int wid, int lane, int wr, int wc, int fr, int fq) const {
#pragma unroll
        for (int ai = 0; ai < 2; ++ai) {
#pragma unroll
            for (int m = 0; m < 4; ++m) {
                const int r = wr * 64 + m * 16 + fr;
#pragma unroll
                for (int bj = 0; bj < 2; ++bj)
#pragma unroll
                    for (int n = 0; n < 2; ++n) {
                        const int c = wc * 8 + bj * 32 + n * 4 + fq;
                        *(PG8_LAS f32x4*)(lds + r * 1024 + ((c ^ (r & 7)) * 16)) = acc[ai][bj][m][n];
                    }
            }
            __syncthreads();
#pragma unroll
            for (int i0 = 0; i0 < 16; i0 += 8) {
                f32x4 xv[8];
#pragma unroll
                for (int i = 0; i < 8; ++i) {
                    const int r = wid * 16 + i0 + i;
                    xv[i] = *(const f32x4*)(xc + (size_t)(u.pm * BM + ai * HALF + r) * 1024 + u.pn * BM + lane * 4);
                }
#pragma unroll
                for (int i = 0; i < 8; ++i) {
                    const int r = wid * 16 + i0 + i;
                    const f32x4 a = *(const PG8_LAS f32x4*)(lds + r * 1024 + ((lane ^ (r & 7)) * 16));
                    *(f32x4*)(xo + (size_t)(u.pm * BM + ai * HALF + r) * 1024 + u.pn * BM + lane * 4) = xv[i] + a;
                }
            }
            __syncthreads();
        }
    }
};
struct EpiG1 {
    static constexpr bool PERM = true, LATE = false;
    const PG8_LAS unsigned char* LB; const float2* CS; unsigned short* P; unsigned short* KVA; unsigned short* IK;
    __device__ __forceinline__ void operator()(const f32x4 (&acc)[2][2][4][2], const Unit& u, int wr, int wc, int fr, int fq) const {
        const int row0 = u.pm * BM + wr * 64 + fr;
#pragma unroll
        for (int bj = 0; bj < 2; ++bj) {
            const int cg = u.pn * BM + bj * HALF + wc * 32;
            const int col = cg + 8 * fq;
            const int c64 = cg & ~63;
            const bool rope = ((cg & 63) == 0) && (c64 < 640 || (c64 >= 768 && c64 < 1088));
            const bool kv8 = (c64 >= 512 && c64 < 768);
            unsigned short* dst; int pitch;
            if (c64 == 1024) { dst = IK + (col - 1024); pitch = 64; }
            else { dst = P + col; pitch = 6208; }
            const f32x4 b0 = *(const PG8_LAS f32x4*)(LB + col * 4), b1 = *(const PG8_LAS f32x4*)(LB + col * 4 + 16);
#pragma unroll
            for (int ai = 0; ai < 2; ++ai)
#pragma unroll
                for (int m = 0; m < 4; ++m) {
                    const int row = row0 + ai * HALF + m * 16;
                    f32x4 v0 = acc[ai][bj][m][0] + b0, v1 = acc[ai][bj][m][1] + b1;
                    if (rope) {
                        f32x4 p0, p1;
#pragma unroll
                        for (int e = 0; e < 4; ++e) { p0[e] = __shfl_xor(v0[e], 16); p1[e] = __shfl_xor(v1[e], 16); }
                        if (fq < 2) {
                            const f32x4* cs = (const f32x4*)(CS + (size_t)row * 8);
                            const f32x4 c01 = cs[0], c23 = cs[1], c45 = cs[2], c67 = cs[3];
                            const float sg = fq == 0 ? -1.f : 1.f;
                            v0[0] = v0[0] * c01[0] + sg * p0[0] * c01[1]; v0[1] = v0[1] * c01[2] + sg * p0[1] * c01[3];
                            v0[2] = v0[2] * c23[0] + sg * p0[2] * c23[1]; v0[3] = v0[3] * c23[2] + sg * p0[3] * c23[3];
                            v1[0] = v1[0] * c45[0] + sg * p1[0] * c45[1]; v1[1] = v1[1] * c45[2] + sg * p1[1] * c45[3];
                            v1[2] = v1[2] * c67[0] + sg * p1[2] * c67[1]; v1[3] = v1[3] * c67[2] + sg * p1[3] * c67[3];
                        }
                    }
                    if (kv8) {
                        int w0 = __builtin_amdgcn_cvt_pk_fp8_f32(v0[0], v0[1], 0, false); w0 = __builtin_amdgcn_cvt_pk_fp8_f32(v0[2], v0[3], w0, true);
                        int w1 = __builtin_amdgcn_cvt_pk_fp8_f32(v1[0], v1[1], 0, false); w1 = __builtin_amdgcn_cvt_pk_fp8_f32(v1[2], v1[3], w1, true);
                        const int co = col - 512, pc = co >> 6, d = co & 63;
                        const int dd = (pc < 2) ? (((d & 31) >> 3) * 16 + (d >> 5) * 8) : d;
                        *(uint2*)((unsigned char*)KVA + (size_t)row * 256 + ((((pc & 1) << 1) | (pc >> 1)) << 6) + dd) = make_uint2((unsigned)w0, (unsigned)w1);
                    } else {
                        u32x4 w; w.x = pk2(v0[0], v0[1]); w.y = pk2(v0[2], v0[3]); w.z = pk2(v1[0], v1[1]); w.w = pk2(v1[2], v1[3]);
                        *(u32x4*)(dst + (size_t)row * pitch) = w;
                    }
                }
        }
    }
};
struct PairOrder {
    int G, c, gatecols;
    __device__ bool next(int i, Unit& u) const {
        const int jj = c + (i / 3) * G, n = i % 3;
        if (jj >= 256) return false;
        const int q = jj & 7, k = jj >> 3;
        const int pmv = q * 8 + (k >> 2), pnv = k & 3;
        u.pm = pmv; u.pn = gatecols ? n * 4 + pnv : pnv; u.seg = gatecols ? 0 : n; return true;
    }
};
struct EpiGate {
    static constexpr bool PERM = true, LATE = false;
    const PG8_LAS unsigned char* LB; unsigned short* GT;
    __device__ __forceinline__ void operator()(const f32x4 (&acc)[2][2][4][2], const Unit& u, int wr, int wc, int fr, int fq) const {
        const int row0 = u.pm * BM + wr * 64 + fr;
#pragma unroll
        for (int bj = 0; bj < 2; ++bj) {
            const int col = u.pn * BM + bj * HALF + wc * 32 + 8 * fq;
            const f32x4 b0 = *(const PG8_LAS f32x4*)(LB + col * 4), b1 = *(const PG8_LAS f32x4*)(LB + col * 4 + 16);
#pragma unroll
            for (int ai = 0; ai < 2; ++ai)
#pragma unroll
                for (int m = 0; m < 4; ++m) {
                    const int row = row0 + ai * HALF + m * 16;
                    const f32x4 v0 = acc[ai][bj][m][0] + b0, v1 = acc[ai][bj][m][1] + b1;
                    u32x4 w; w.x = pk2(sigmoidf(v0[0]), sigmoidf(v0[1])); w.y = pk2(sigmoidf(v0[2]), sigmoidf(v0[3]));
                    w.z = pk2(sigmoidf(v1[0]), sigmoidf(v1[1])); w.w = pk2(sigmoidf(v1[2]), sigmoidf(v1[3]));
                    *(u32x4*)(GT + (size_t)row * 3072 + col) = w;
                }
        }
    }
};
struct EpiMerge {
    static constexpr bool PERM = true, LATE = false;
    const unsigned short* GT; unsigned short* MG;
    __device__ __forceinline__ void operator()(const f32x4 (&acc)[2][2][4][2], const Unit& u, int wr, int wc, int fr, int fq) const {
        const int row0 = u.pm * BM + wr * 64 + fr;
#pragma unroll
        for (int bj = 0; bj < 2; ++bj) {
            const int col = u.pn * BM + bj * HALF + wc * 32 + 8 * fq;
#pragma unroll
            for (int ai = 0; ai < 2; ++ai)
#pragma unroll
                for (int m = 0; m < 4; ++m) {
                    const int row = row0 + ai * HALF + m * 16;
                    const u32x4 gq = *(const u32x4*)(GT + (size_t)row * 3072 + u.seg * 1024 + col);
                    u32x4 pq = {0u, 0u, 0u, 0u};
                    if (u.seg > 0) pq = *(const u32x4*)(MG + (size_t)row * 1024 + col);
                    const f32x4 a0 = acc[ai][bj][m][0], a1 = acc[ai][bj][m][1];
                    u32x4 w;
                    w.x = pk2(bflo(pq.x) + bflo(gq.x) * a0[0], bfhi(pq.x) + bfhi(gq.x) * a0[1]);
                    w.y = pk2(bflo(pq.y) + bflo(gq.y) * a0[2], bfhi(pq.y) + bfhi(gq.y) * a0[3]);
                    w.z = pk2(bflo(pq.z) + bflo(gq.z) * a1[0], bfhi(pq.z) + bfhi(gq.z) * a1[1]);
                    w.w = pk2(bflo(pq.w) + bflo(gq.w) * a1[2], bfhi(pq.w) + bfhi(gq.w) * a1[3]);
                    *(u32x4*)(MG + (size_t)row * 1024 + col) = w;
                }
        }
    }
};
}

__device__ __forceinline__ void phase_g1(const Params& p, int l, int b, unsigned char* smem) {
    unsigned char* ws_ = opaque_ptr(p.ws);
    const int tid0 = opaque_tid(), lane = tid0 & 63, wave = tid0 >> 6, wm = wave >> 1, wn = wave & 1;
    const u16* XB = (const u16*)(ws_ + OFF_XB) + (size_t)b * SEQ * 1024;
    const u16* W = (const u16*)(ws_ + OFF_WT1) + (size_t)l * N1 * 1024;
    const float* B1 = (const float*)(ws_ + OFF_B1) + l * N1;
    const float2* CS = (const float2*)(ws_ + OFF_CS);
    u16* P = (u16*)(ws_ + OFF_P); u16* KVA = (u16*)(ws_ + OFF_KVA); u16* IK = (u16*)(ws_ + OFF_IK); float* SM = (float*)(ws_ + OFF_SM);
    {
        __syncthreads();
        for (int i = tid0; i < 6144 / 4; i += 512) *(float4*)(smem + pg8::STAGE_BYTES + i * 16) = *(const float4*)(B1 + i * 4);
        __syncthreads();
    }
    {
        pg8::Gemm g; g.A = XB; g.Bt = W; g.lda = 1024; g.ldb = 1024; g.K = 1024; g.segA = 0; g.segB = 0;
        pg8::StaticOrder S; S.init(SEQ, 6144, (int)gridDim.x, (int)blockIdx.x);
        pg8::EpiG1 E; E.LB = (const PG8_LAS unsigned char*)(smem + pg8::STAGE_BYTES); E.CS = CS; E.P = P; E.KVA = KVA; E.IK = IK;
        pg8::gemm_phase((PG8_LAS unsigned char*)smem, g, S, E);
    }
    GEMM_DECL(1)
    constexpr int NLT = SEQ / 128;
    if ((int)blockIdx.x < NLT) GEMM_ISSUE(XB + (size_t)blockIdx.x * 128 * 1024, 1024, W + (size_t)48 * 128 * 1024, 1024);
    for (int tile = blockIdx.x; tile < NLT; tile += gridDim.x) {
        f32x16 acc[1][2];
#pragma unroll
        for (int j = 0; j < 2; ++j)
#pragma unroll
            for (int e = 0; e < 16; ++e) acc[0][j][e] = 0.f;
        GEMM_RUN(1024, acc);
        { const int nx = tile + gridDim.x; if (nx < NLT) GEMM_ISSUE(XB + (size_t)nx * 128 * 1024, 1024, W + (size_t)48 * 128 * 1024, 1024); }
        unsigned char* wreg = smem + wave * (32 * 144);
#pragma unroll
        for (int nt = 0; nt < 2; ++nt) {
            const int n = 6144 + wn * 64 + nt * 32 + (lane & 31);
            const float bias = B1[n];
#pragma unroll
            for (int reg = 0; reg < 16; ++reg) {
                const int rl = (reg & 3) + 8 * (reg >> 2) + 4 * (lane >> 5);
                const int row = tile * 128 + wm * 32 + rl;
                const float v = acc[0][nt][reg] + bias;
                if (wn == 0) *(u16*)(wreg + rl * 144 + (nt * 32 + (lane & 31)) * 2) = f2bf(v);
                else if (n < 6220) SM[(size_t)row * 16 + (n - 6208)] = v;
            }
        }
        __builtin_amdgcn_fence(__ATOMIC_RELEASE, "workgroup");
        __builtin_amdgcn_wave_barrier();
        __builtin_amdgcn_fence(__ATOMIC_ACQUIRE, "workgroup");
        if (wn == 0) {
            const int ch = lane & 7;
#pragma unroll
            for (int i = 0; i < 4; ++i) {
                const int rl = (lane >> 3) + 8 * i;
                const uint4 d = *(const uint4*)(wreg + rl * 144 + ch * 16);
                *(uint4*)(P + (size_t)(tile * 128 + wm * 32 + rl) * PLD + 6144 + ch * 8) = d;
            }
        }
        __syncthreads();
    }
}
__device__ __forceinline__ void phase_g2(const Params& p, int l, int b, unsigned char* smem) {
    unsigned char* ws_ = opaque_ptr(p.ws);
    u16* GT = (u16*)(ws_ + OFF_P);
    {
        pg8::Gemm g; g.A = (const u16*)(ws_ + OFF_XB) + (size_t)b * SEQ * 1024; g.Bt = (const u16*)(ws_ + OFF_WG) + (size_t)l * 3072 * 1024;
        g.lda = 1024; g.ldb = 1024; g.K = 1024; g.segA = 0; g.segB = 0;
        pg8::PairOrder S; S.G = (int)gridDim.x; S.c = (int)blockIdx.x; S.gatecols = 1;
        {
            const float* BG = (const float*)(ws_ + OFF_BG) + l * 3072;
            __syncthreads();
            for (int i = opaque_tid(); i < 3072 / 4; i += 512) *(float4*)(smem + pg8::STAGE_BYTES + i * 16) = *(const float4*)(BG + i * 4);
            __syncthreads();
        }
        pg8::EpiGate E; E.LB = (const PG8_LAS unsigned char*)(smem + pg8::STAGE_BYTES); E.GT = GT;
        pg8::gemm_phase((PG8_LAS unsigned char*)smem, g, S, E);
    }
    {
        pg8::Gemm g; g.A = (const u16*)(ws_ + OFF_YBR); g.Bt = (const u16*)(ws_ + OFF_WB) + (size_t)l * 3 * 1024 * 512;
        g.lda = 1536; g.ldb = 512; g.K = 512; g.segA = 512 * 2; g.segB = (size_t)1024 * 512 * 2;
        pg8::PairOrder S; S.G = (int)gridDim.x; S.c = (int)blockIdx.x; S.gatecols = 0;
        pg8::EpiMerge E; E.GT = GT; E.MG = (u16*)(ws_ + OFF_MG);
        pg8::gemm_phase((PG8_LAS unsigned char*)smem, g, S, E);
    }
}

__device__ __forceinline__ void phase_g3(const Params& p, int l, int b, unsigned char* smem) {
    unsigned char* ws_ = opaque_ptr(p.ws);
    pg8::Gemm g; g.A = (const u16*)(ws_ + OFF_MG); g.Bt = (const u16*)(ws_ + OFF_WO) + (size_t)l * 1024 * 1024; g.lda = 1024; g.ldb = 1024; g.K = 1024; g.segA = 0; g.segB = 0;
    pg8::StaticOrder S; S.init(SEQ, 1024, (int)gridDim.x, (int)blockIdx.x);
    pg8::EpiResid E; E.xc = (l == 0 ? p.x : p.out) + (size_t)b * SEQ * 1024; E.xo = p.out + (size_t)b * SEQ * 1024;
    pg8::gemm_phase((PG8_LAS unsigned char*)smem, g, S, E);
}

constexpr int HST = 257;
constexpr int CAP = 384;
constexpr int A_HIST = 0, A_HISTF = 33280, A_HIST2 = 66560, A_CKEY = 0, A_CIDX = 49152, A_PL = 0, A_SEL = 99840, A_ST = A_SEL + 16384, A_FLAG = A_ST + 2048, A_BQ = A_FLAG + 1024;
static_assert(32 * HST * 4 <= A_HISTF && A_HIST2 + 32 * HST * 4 <= A_SEL && 8 * 8192 <= A_SEL && A_CIDX + 32 * CAP * 4 <= A_SEL && A_BQ + 16384 <= LDS_BYTES - 64, "a lds");
__device__ __forceinline__ void a_unit(const Params& p, int c, int hf, unsigned char* smem) {
    unsigned char* ws_ = opaque_ptr(p.ws);
    const int tid = opaque_tid(), lane = tid & 63, wave = tid >> 6;
    const int q = lane & 31, hh = lane >> 5;
    const u16* P = (const u16*)(ws_ + OFF_P); const u16* KVA = (const u16*)(ws_ + OFF_KVA); const u16* IK = (const u16*)(ws_ + OFF_IK);
    const float* SM = (const float*)(ws_ + OFF_SM); u16* YBR = (u16*)(ws_ + OFF_YBR);
    u32* hist = (u32*)(smem + A_HIST); u16* sel = (u16*)(smem + A_SEL); u32* ckey = (u32*)(smem + A_CKEY); u32* cidx = (u32*)(smem + A_CIDX);
    u32* st = (u32*)(smem + A_ST); u32* flag = (u32*)(smem + A_FLAG);
    const int t0 = c * 64 + hf * 32;
    const int nadm = 64 * (c + 1);
    for (int rep_sel = 0; rep_sel < DUP_ASEL; ++rep_sel) {
    __syncthreads();
    if (c < 4) {
        for (int i = tid; i < 32 * 256; i += 512) { const int s = i & 255; sel[i] = (u16)(s < nadm ? s : 0); }
    } else {
        const size_t tq = (size_t)(t0 + q);
        bf8 bq[4][4];
        float w[4];
        float ssq = 0.f;
#pragma unroll
        for (int h = 0; h < 4; ++h) {
            w[h] = SM[tq * 16 + h] * 0.0625f;
            float n2 = 0.f;
#pragma unroll
            for (int s = 0; s < 4; ++s) {
                const uint4 raw = *(const uint4*)(P + tq * PLD + C_IQ + h * 64 + s * 16 + hh * 8);
                bq[h][s] = u4_to_bf8(raw);
                n2 += bflo(raw.x) * bflo(raw.x) + bfhi(raw.x) * bfhi(raw.x) + bflo(raw.y) * bflo(raw.y) + bfhi(raw.y) * bfhi(raw.y)
                    + bflo(raw.z) * bflo(raw.z) + bfhi(raw.z) * bfhi(raw.z) + bflo(raw.w) * bflo(raw.w) + bfhi(raw.w) * bfhi(raw.w);
            }
            n2 += __shfl_xor(n2, 32);
            ssq += w[h] * w[h] * n2;
        }
        unsigned char* bql = smem + A_BQ + lane * 16;
        if (wave == 0) {
#pragma unroll
            for (int h = 0; h < 4; ++h)
#pragma unroll
                for (int s = 0; s < 4; ++s) *(bf8*)(bql + (h * 4 + s) * 1024) = bq[h][s];
        }
        const float sdev = sqrtf(ssq);
        const int binK = max((int)(__float_as_uint(4.f * sdev) >> 20) - 126, 0);
        const int nkt = 2 * (c + 1);
        if (tid < 32) { st[0 * 32 + tid] = 0; st[1 * 32 + tid] = 0; st[2 * 32 + tid] = 256; st[3 * 32 + tid] = 0; st[4 * 32 + tid] = 0; st[5 * 32 + tid] = 0; st[6 * 32 + tid] = 0; st[7 * 32 + tid] = 0; }
        auto load_tile = [&](int kt, bf8 (&a)[4]) {
            const u16* kr = IK + (size_t)(kt * 32 + q) * 64 + hh * 8;
#pragma unroll
            for (int s = 0; s < 4; ++s) a[s] = ld_bf8(kr + s * 16);
        };
        auto score_tile = [&](const bf8 (&a)[4], f32x16& sc) {
            f32x16 acc0, acc1;
            f32x2 s2[8];
#pragma unroll
            for (int e = 0; e < 16; ++e) { acc0[e] = 0.f; acc1[e] = 0.f; }
#pragma unroll
            for (int s = 0; s < 4; ++s) acc0 = mfma32(a[s], ld_bf8(bql + s * 1024), acc0);
#pragma unroll
            for (int s = 0; s < 4; ++s) acc1 = mfma32(a[s], ld_bf8(bql + (4 + s) * 1024), acc1);
            __builtin_amdgcn_sched_barrier(0);
            {
                const f32x2 wv = {w[0], w[0]}, z2 = {0.f, 0.f};
#pragma unroll
                for (int k = 0; k < 8; ++k) { s2[k].x = fma_s(relu_i(acc0[2 * k]), wv.x, 0.f); s2[k].y = fma_s(relu_i(acc0[2 * k + 1]), wv.x, 0.f); }
            }
#pragma unroll
            for (int e = 0; e < 16; ++e) acc0[e] = 0.f;
            {
                bf8 b2[4];
#pragma unroll
                for (int s = 0; s < 4; ++s) b2[s] = ld_bf8(bql + (8 + s) * 1024);
#pragma unroll
                for (int s = 0; s < 4; ++s) acc0 = mfma32(a[s], b2[s], acc0);
            }
            __builtin_amdgcn_sched_barrier(0);
            {
                const f32x2 wv = {w[1], w[1]};
#pragma unroll
                for (int k = 0; k < 8; ++k) { s2[k].x = fma_s(relu_i(acc1[2 * k]), wv.x, s2[k].x); s2[k].y = fma_s(relu_i(acc1[2 * k + 1]), wv.x, s2[k].y); }
            }
#pragma unroll
            for (int e = 0; e < 16; ++e) acc1[e] = 0.f;
            {
                bf8 b3[4];
#pragma unroll
                for (int s = 0; s < 4; ++s) b3[s] = ld_bf8(bql + (12 + s) * 1024);
#pragma unroll
                for (int s = 0; s < 4; ++s) acc1 = mfma32(a[s], b3[s], acc1);
            }
            __builtin_amdgcn_sched_barrier(0);
            {
                const f32x2 wv = {w[2], w[2]};
#pragma unroll
                for (int k = 0; k < 8; ++k) { s2[k].x = fma_s(relu_i(acc0[2 * k]), wv.x, s2[k].x); s2[k].y = fma_s(relu_i(acc0[2 * k + 1]), wv.x, s2[k].y); }
            }
            {
                const f32x2 wv = {w[3], w[3]};
#pragma unroll
                for (int k = 0; k < 8; ++k) { s2[k].x = fma_s(relu_i(acc1[2 * k]), wv.x, s2[k].x); s2[k].y = fma_s(relu_i(acc1[2 * k + 1]), wv.x, s2[k].y); }
            }
#pragma unroll
            for (int k = 0; k < 8; ++k) { sc[2 * k] = s2[k].x; sc[2 * k + 1] = s2[k].y; }
        };
        auto fold_head = [&](const f32x16& acc, const int h, f32x2 (&s2)[8]) {
            const f32x2 wv = {w[h], w[h]}, z2 = {0.f, 0.f};
#pragma unroll
            for (int k = 0; k < 8; ++k) { s2[k].x = fma_s(relu_i(acc[2 * k]), wv.x, (h == 0) ? z2.x : s2[k].x); s2[k].y = fma_s(relu_i(acc[2 * k + 1]), wv.x, (h == 0) ? z2.y : s2[k].y); }
        };
        f32x16 zero16;
#pragma unroll
        for (int e = 0; e < 16; ++e) zero16[e] = 0.f;
        auto bin_mag = [&](float v) -> int {
            const int e = (int)((__float_as_uint(v) >> 20) & 0x7FFu);
            return min(max(e - binK, 0), 126);
        };
        auto bin_of = [&](float v) -> u32 {
            const int sg = __float_as_int(v) >> 31;
            return (u32)((bin_mag(v) ^ sg) + 128);
        };
        auto sub_of = [&](float v) -> u32 {
            const u32 ab = __float_as_uint(v) & 0x7FFFFFFFu;
            const long long lo = (long long)(bin_mag(v) + binK) << 20;
            long long d = ((long long)ab - lo) >> 12;
            d = d < 0 ? 0 : (d > 255 ? 255 : d);
            return (__float_as_int(v) < 0) ? (u32)(255 - d) : (u32)d;
        };
        u32* hist2 = (u32*)(smem + A_HIST2);
        int level = 0;
#pragma unroll 1
        for (;; ++level) {
            for (int i = tid; i < 32 * HST; i += 512) { hist[i] = 0; if (level == 0) hist2[i] = 0; }
            __syncthreads();
            const int sh = (level == 7) ? 0 : 54 - 8 * level;
            const int bits = (level == 7) ? 6 : 8;
            if (level == 0) {
              if (wave < nkt) {
                bf8 ka[4], kb[4];
                load_tile(wave, ka);
                load_tile(wave + 8 < nkt ? wave + 8 : wave, kb);
                f32x16 sc; score_tile(ka, sc);
                auto hist_step = [&](const int kt, const bf8 (&ac)[4]) {
                    f32x16 acc[2];
                    f32x2 s2[8];
                    u32 zc = 0;
#pragma unroll
                    for (int e = 0; e < 16; ++e) {
                        const int ks = (e >> 1) & 3;
                        if (e == 8) fold_head(acc[0], 0, s2);
                        if (e == 9) fold_head(acc[1], 1, s2);
                        acc[e & 1] = (ks == 0) ? mfma32(ac[ks], bq[2 * (e >> 3) + (e & 1)][ks], zero16) : mfma32(ac[ks], bq[2 * (e >> 3) + (e & 1)][ks], acc[e & 1]);
                        atomicAdd(&hist[q * HST + bin_of(sc[e])], 1u);
                        count_zero(zc, sc[e]);
                        __builtin_amdgcn_sched_barrier(0);
                    }
                    atomicAdd(&hist2[q * HST + (255u - (u32)(kt >> 1))], zc);
                    fold_head(acc[0], 2, s2); fold_head(acc[1], 3, s2);
#pragma unroll
                    for (int k = 0; k < 8; ++k) { sc[2 * k] = s2[k].x; sc[2 * k + 1] = s2[k].y; }
                };
#pragma unroll 1
                for (int kt = wave; kt < nkt; kt += 16) {
                    load_tile(kt + 16 < nkt ? kt + 16 : wave, ka);
                    hist_step(kt, kb);
                    if (kt + 8 >= nkt) break;
                    load_tile(kt + 24 < nkt ? kt + 24 : wave, kb);
                    hist_step(kt + 8, ka);
                }
              }
            } else {
                const u64 pref = ((u64)st[1 * 32 + q] << 32) | st[0 * 32 + q];
                const bool qdone = st[3 * 32 + q] != 0;
                const int sh_hi = sh + bits;
                const u32 dmask = (level == 7) ? 63u : 255u;
                bf8 an[4]; load_tile(wave < nkt ? wave : 0, an);
#pragma unroll 1
                for (int kt = wave; kt < nkt; kt += 8) {
                    bf8 ac[4];
#pragma unroll
                    for (int s = 0; s < 4; ++s) ac[s] = an[s];
                    load_tile(kt + 8 < nkt ? kt + 8 : kt, an);
                    f32x16 sc; score_tile(ac, sc);
#pragma unroll
                    for (int reg = 0; reg < 16; ++reg) {
                        const u32 u = __float_as_uint(sc[reg]);
                        const u32 key = (u & 0x80000000u) ? ~u : (u | 0x80000000u);
                        const u32 idx = kt * 32 + (reg & 3) + 8 * (reg >> 2) + 4 * hh;
                        const u64 K = ((u64)bin_of(sc[reg]) << 54) | ((u64)sub_of(sc[reg]) << 46) | ((u64)key << 14) | (u64)(16383u - idx);
                        if (!qdone && (K >> sh_hi) == pref) atomicAdd(&hist[q * HST + (u32)((K >> sh) & dmask)], 1u);
                    }
                }
            }
            __syncthreads();
            if (lane == 0) flag[wave] = 0;
            auto find_cross = [&](const u32* hrow, u32 r, u32& digit, u32& ac, u32& bucket) {
                const int lb = (63 - lane) * 4;
                uint4 h4; h4.x = hrow[lb]; h4.y = hrow[lb + 1]; h4.z = hrow[lb + 2]; h4.w = hrow[lb + 3];
                const u32 s4 = h4.x + h4.y + h4.z + h4.w;
                const u32 v = scan_add_u32(s4);
                const u32 above = v - s4;
                const bool hit = above < r && r <= v;
                u32 a = above; u32 d, bk;
                if (a + h4.w >= r) { d = 3; bk = h4.w; }
                else { a += h4.w; if (a + h4.z >= r) { d = 2; bk = h4.z; }
                    else { a += h4.z; if (a + h4.y >= r) { d = 1; bk = h4.y; } else { a += h4.y; d = 0; bk = h4.x; } } }
                const u64 mk = __ballot(hit);
                const int src_lane = mk ? (__ffsll((long long)mk) - 1) : 0;
                digit = (u32)__builtin_amdgcn_readlane((int)((u32)lb + d), src_lane); ac = (u32)__builtin_amdgcn_readlane((int)a, src_lane); bucket = (u32)__builtin_amdgcn_readlane((int)bk, src_lane);
            };
#pragma unroll 1
            for (int j = 0; j < 4; ++j) {
                const int qq = 4 * wave + j;
                if (st[3 * 32 + qq] != 0) continue;
                const u32 r = st[2 * 32 + qq];
                u32 digit, ac, bucket;
                find_cross(hist + qq * HST, r, digit, ac, bucket);
                u32 pdig = digit;
                u32 shv = (u32)sh, rn = r - ac, cls = (level == 0) ? 0u : 2u;
                bool dn = (bucket <= (u32)CAP) || (level == 7);
                if (!dn && level == 0) {
                    if (digit == 128u) {
                        const u32* h2 = hist2 + qq * HST;
                        u32 nz = h2[lane * 4] + h2[lane * 4 + 1] + h2[lane * 4 + 2] + h2[lane * 4 + 3];
                        nz = (u32)__builtin_amdgcn_readlane((int)scan_add_u32(nz), 63);
                        const u32 npos = bucket - nz;
                        if (rn > npos) {
                            u32 d2, ac2, bk2;
                            find_cross(h2, rn - npos, d2, ac2, bk2);
                            pdig = d2; shv = 6u; rn = rn - npos - ac2; cls = 1u; dn = true;
                        }
                    }
                }
                if (lane == 0) {
                    u64 pf;
                    if (cls == 1u) pf = ((u64)128u << 48) | ((u64)0x80000000u << 8) | (u64)pdig;
                    else { pf = ((u64)st[1 * 32 + qq] << 32) | st[0 * 32 + qq]; pf = (pf << bits) | (u64)pdig; }
                    st[0 * 32 + qq] = (u32)pf; st[1 * 32 + qq] = (u32)(pf >> 32);
                    st[2 * 32 + qq] = rn; st[3 * 32 + qq] = dn ? 1u : 0u; st[6 * 32 + qq] = shv; st[7 * 32 + qq] = cls;
                    if (!dn) flag[wave] = 1;
                }
            }
            __syncthreads();
            u32 any = 0;
#pragma unroll
            for (int i = 0; i < 8; ++i) any |= flag[i];
            if (!any) break;
        }
        __syncthreads();
        {
            const u64 pref = ((u64)st[1 * 32 + q] << 32) | st[0 * 32 + q];
            const int shq = (int)st[6 * 32 + q];
            const u32 cls = st[7 * 32 + q];
            bf8 an[4]; load_tile(wave < nkt ? wave : 0, an);
            if (level == 0) {
                const bool cls1 = (cls == 1u);
                const u32 pb = cls1 ? 128u : (u32)pref;
                auto key_to_float = [&](u32 k) -> float { return __uint_as_float((k & 0x80000000u) ? (k ^ 0x80000000u) : ~k); };
                auto first_score_with_bin = [&](u32 B) -> float {
                    u32 lo = 0x007FFFFFu, hi = 0xFF800000u;
                    if (bin_of(key_to_float(hi)) < B) return __builtin_inff();
#pragma unroll 1
                    for (int it = 0; it < 32; ++it) {
                        if (lo >= hi) break;
                        const u32 mid = lo + ((hi - lo) >> 1);
                        if (bin_of(key_to_float(mid)) >= B) hi = mid; else lo = mid + 1;
                    }
                    return key_to_float(hi);
                };
                const float vs = cls1 ? 1.4e-45f : first_score_with_bin(pb + 1u);
                const float vc = cls1 ? __builtin_inff() : first_score_with_bin(pb);
                const u32 d2q = (u32)pref & 0xFFu;
                if (wave < nkt) {
                bf8 kb[4];
                load_tile(wave + 8 < nkt ? wave + 8 : wave, kb);
                f32x16 sc; score_tile(an, sc);
                auto coll_step = [&](const int kt, const bf8 (&ac)[4]) {
                    f32x16 acc[2];
                    f32x2 s2[8];
                    const u32 dgt = 255u - (u32)(kt >> 1);
                    const float vst = (cls1 && dgt > d2q) ? 0.f : vs;
                    const float vct = (cls1 && dgt == d2q) ? 0.f : vc;
                    u32 smask = 0, cmask = 0;
                    {
#pragma unroll
                        for (int e = 0; e < 16; ++e) {
                            const int ks = (e >> 1) & 3;

                            if (e == 8) fold_head(acc[0], 0, s2);
                            if (e == 9) fold_head(acc[1], 1, s2);
                            acc[e & 1] = (ks == 0) ? mfma32(ac[ks], bq[2 * (e >> 3) + (e & 1)][ks], zero16) : mfma32(ac[ks], bq[2 * (e >> 3) + (e & 1)][ks], acc[e & 1]);
                            shift_in_ge(smask, sc[e], vst); shift_in_ge(cmask, sc[e], vct);
                            __builtin_amdgcn_sched_barrier(0);
                        }
                    }
                    cmask &= ~smask;
                    const u32 kbase = kt * 32 + 4 * hh;
                    if (smask | cmask) {
                        u32 spos = 0, cpos = 0;
                        if (cmask) cpos = atomicAdd(&st[5 * 32 + q], (u32)__popc(cmask));
                        if (smask) spos = atomicAdd(&st[4 * 32 + q], (u32)__popc(smask));
                        while (cmask) {
                            const int reg = 15 - (__ffs((int)cmask) - 1); cmask &= cmask - 1;
                            const float v = pick16(sc, reg);
                            const u32 u = __float_as_uint(v); ckey[q * CAP + cpos] = (u & 0x80000000u) ? ~u : (u | 0x80000000u); cidx[q * CAP + cpos] = kbase + (reg & 3) + 8 * (reg >> 2);
                            ++cpos;
                        }
                        while (smask) {
                            const int reg = 15 - (__ffs((int)smask) - 1); smask &= smask - 1;
                            sel[q * 256 + spos] = (u16)(kbase + (reg & 3) + 8 * (reg >> 2));
                            ++spos;
                        }
                    }
                    fold_head(acc[0], 2, s2); fold_head(acc[1], 3, s2);
#pragma unroll
                    for (int k = 0; k < 8; ++k) { sc[2 * k] = s2[k].x; sc[2 * k + 1] = s2[k].y; }
                };
#pragma unroll 1
                for (int kt = wave; kt < nkt; kt += 16) {
                    load_tile(kt + 16 < nkt ? kt + 16 : wave, an);
                    coll_step(kt, kb);
                    if (kt + 8 >= nkt) break;
                    load_tile(kt + 24 < nkt ? kt + 24 : wave, kb);
                    coll_step(kt + 8, an);
                }
                }
            } else {
#pragma unroll 1
                for (int kt = wave; kt < nkt; kt += 8) {
                    bf8 ac[4];
#pragma unroll
                    for (int s = 0; s < 4; ++s) ac[s] = an[s];
                    load_tile(kt + 8 < nkt ? kt + 8 : kt, an);
                    f32x16 sc; score_tile(ac, sc);
#pragma unroll
                    for (int reg = 0; reg < 16; ++reg) {
                        const u32 u = __float_as_uint(sc[reg]);
                        const u32 key = (u & 0x80000000u) ? ~u : (u | 0x80000000u);
                        const u32 idx = kt * 32 + (reg & 3) + 8 * (reg >> 2) + 4 * hh;
                        const u64 K = ((u64)bin_of(sc[reg]) << 54) | ((u64)sub_of(sc[reg]) << 46) | ((u64)key << 14) | (u64)(16383u - idx);
                        const u64 e = K >> shq;
                        if (e >= pref) {
                            if (e > pref) { const u32 pos = atomicAdd(&st[4 * 32 + q], 1u); if (pos < 256) sel[q * 256 + pos] = (u16)idx; }
                            else { const u32 pos = atomicAdd(&st[5 * 32 + q], 1u); if (pos < (u32)CAP) { ckey[q * CAP + pos] = key; cidx[q * CAP + pos] = idx; } }
                        }
                    }
                }
            }
        }
        __syncthreads();
        auto rank_q = [&](auto TT, const int qq, const u32 nc, const u32 r) {
            constexpr int T = decltype(TT)::value;
            u32 kh[T], il[T];
#pragma unroll
            for (int t = 0; t < T; ++t) {
                const u32 i = lane + 64 * t; const bool valid = i < nc;
                kh[t] = valid ? ckey[qq * CAP + i] : 0u; il[t] = valid ? cidx[qq * CAP + i] : 0xFFFFFFFFu;
            }
            u32 thr = 0;
#pragma unroll 1
            for (int bpos = 31; bpos >= 0; --bpos) {
                const u32 test = thr | (1u << bpos);
                u32 cnt = 0;
#pragma unroll
                for (int t = 0; t < T; ++t) cnt += (u32)__popcll(__ballot(kh[t] >= test));
                if (cnt >= r) thr = test;
            }
            u32 cgt = 0, ceq = 0;
#pragma unroll
            for (int t = 0; t < T; ++t) { cgt += (u32)__popcll(__ballot(kh[t] > thr)); ceq += (u32)__popcll(__ballot(kh[t] == thr && il[t] != 0xFFFFFFFFu)); }
            const u32 need = r - cgt;
            u32 xi = 0xFFFFFFFEu;
            if (need < ceq) {
                xi = 0;
#pragma unroll 1
                for (int bpos = 13; bpos >= 0; --bpos) {
                    const u32 test = xi | (1u << bpos);
                    u32 cnt = 0;
#pragma unroll
                    for (int t = 0; t < T; ++t) cnt += (u32)__popcll(__ballot(kh[t] == thr && il[t] < test));
                    if (cnt < need) xi = test;
                }
            }
            u32 base = (u32)__builtin_amdgcn_readfirstlane((int)st[4 * 32 + qq]);
#pragma unroll
            for (int t = 0; t < T; ++t) {
                const bool take = kh[t] > thr || (kh[t] == thr && il[t] <= xi);
                const u64 m = __ballot(take);
                const u32 pos = base + __builtin_amdgcn_mbcnt_hi((u32)(m >> 32), __builtin_amdgcn_mbcnt_lo((u32)m, 0u));
                if (take && pos < 256) sel[qq * 256 + pos] = (u16)il[t];
                base += (u32)__popcll(m);
            }
        };
#pragma unroll 1
        for (int j = 0; j < 4; ++j) {
            const int qq = 4 * wave + j;
            const u32 nc = (u32)__builtin_amdgcn_readfirstlane((int)min(st[5 * 32 + qq], (u32)CAP)), r = (u32)__builtin_amdgcn_readfirstlane((int)st[2 * 32 + qq]);
            if (nc == 0u || r == 0u) continue;
            if (nc <= 64u) rank_q(IC<1>{}, qq, nc, r);
            else if (nc <= 128u) rank_q(IC<2>{}, qq, nc, r);
            else if (nc <= 256u) rank_q(IC<4>{}, qq, nc, r);
            else rank_q(IC<6>{}, qq, nc, r);
        }
    }
    }
    __syncthreads();
    {
        u16* SELG = (u16*)(ws_ + OFF_SEL) + (size_t)t0 * 256;
        for (int i = tid; i < 32 * 256 / 8; i += 512) *(uint4*)(SELG + i * 8) = *(const uint4*)(sel + i * 8);
    }
    __syncthreads();
}

constexpr int T_SEL = 0, T_PL = 8 * 512, T_RED = T_PL + 8 * 4096;
__device__ __forceinline__ void att_unit(const Params& p, int c, int hf, int g, int jbeg, int jend, unsigned char* smem) {
    unsigned char* ws_ = opaque_ptr(p.ws);
    const int tid = opaque_tid(), lane = tid & 63, wave = tid >> 6;
    const u16* P = (const u16*)(ws_ + OFF_P); const unsigned char* KV8 = (const unsigned char*)(ws_ + OFF_KVA); u16* YBR = (u16*)(ws_ + OFF_YBR);
    const u16* SELG = (const u16*)(ws_ + OFF_SEL);
    const int t0 = c * 64 + hf * 32;
    const int nadm = 64 * (c + 1);
    const int nvalid = nadm < 256 ? nadm : 256;
    u16* selw = (u16*)(smem + T_SEL) + wave * 256;
    float* pl = (float*)(smem + T_PL) + wave * 1024;
    const int hc = lane & 15, lg = lane >> 4;
    __syncthreads();
    for (int rep_att = 0; rep_att < DUP_AATT; ++rep_att) {
    uint2 selnx = *(const uint2*)(SELG + (size_t)(t0 + 4 * wave + jbeg) * 256 + lane * 4);
    uint4 qx0 = make_uint4(0, 0, 0, 0), qx1 = qx0;
    if (hc < 4) { const u16* qp = P + (size_t)(t0 + 4 * wave + jbeg) * PLD + C_AQ + (g * 4 + hc) * 64 + lg * 8; qx0 = *(const uint4*)qp; qx1 = *(const uint4*)(qp + 32); }
#pragma unroll 1
    for (int j = jbeg; j < jend; ++j) {
        const size_t tq = (size_t)(t0 + 4 * wave + j);
        *(uint2*)(selw + lane * 4) = selnx;
        const uint4 qn0 = qx0, qn1 = qx1;
        if (j + 1 < jend) {
            selnx = *(const uint2*)(SELG + (tq + 1) * 256 + lane * 4);
            if (hc < 4) { const u16* qp = P + (tq + 1) * PLD + C_AQ + (g * 4 + hc) * 64 + lg * 8; qx0 = *(const uint4*)qp; qx1 = *(const uint4*)(qp + 32); }
        }
        const uint2 zzq = *(const uint2*)(P + tq * PLD + C_AZ + (g * 4 + (lane >> 4)) * 64 + (lane & 15) * 4);
        long bqa[2];
        {
            int a0 = __builtin_amdgcn_cvt_pk_fp8_f32(bflo(qn0.x), bfhi(qn0.x), 0, false); a0 = __builtin_amdgcn_cvt_pk_fp8_f32(bflo(qn0.y), bfhi(qn0.y), a0, true);
            int a1 = __builtin_amdgcn_cvt_pk_fp8_f32(bflo(qn0.z), bfhi(qn0.z), 0, false); a1 = __builtin_amdgcn_cvt_pk_fp8_f32(bflo(qn0.w), bfhi(qn0.w), a1, true);
            int c0 = __builtin_amdgcn_cvt_pk_fp8_f32(bflo(qn1.x), bfhi(qn1.x), 0, false); c0 = __builtin_amdgcn_cvt_pk_fp8_f32(bflo(qn1.y), bfhi(qn1.y), c0, true);
            int c1 = __builtin_amdgcn_cvt_pk_fp8_f32(bflo(qn1.z), bfhi(qn1.z), 0, false); c1 = __builtin_amdgcn_cvt_pk_fp8_f32(bflo(qn1.w), bfhi(qn1.w), c1, true);
            bqa[0] = (long)(((unsigned long long)(unsigned)a1 << 32) | (unsigned)a0);
            bqa[1] = (long)(((unsigned long long)(unsigned)c1 << 32) | (unsigned)c0);
        }
        __builtin_amdgcn_fence(__ATOMIC_RELEASE, "workgroup");
        __builtin_amdgcn_wave_barrier();
        __builtin_amdgcn_fence(__ATOMIC_ACQUIRE, "workgroup");
        const int ks = lane >> 2, dc = lane & 3;
        const unsigned char* vb = KV8 + g * 128 + 64 + dc * 16;
        long ka0[16], ka1[16];
#pragma unroll
        for (int kt = 0; kt < 16; ++kt) {
            const uint4 kk = *(const uint4*)(KV8 + (size_t)selw[kt * 16 + hc] * 256 + g * 128 + lg * 16);
            ka0[kt] = (long)(((unsigned long long)kk.y << 32) | kk.x); ka1[kt] = (long)(((unsigned long long)kk.w << 32) | kk.z);
        }
        uint4 vvs[16];
#pragma unroll
        for (int it = 0; it < 16; ++it) vvs[it] = *(const uint4*)(vb + (size_t)selw[it * 16 + ks] * 256);
        __builtin_amdgcn_sched_barrier(0);
        f32x4 sacc[16];
#pragma unroll
        for (int kt = 0; kt < 16; ++kt) {
            f32x4 z = {0.f, 0.f, 0.f, 0.f};
            z = __builtin_amdgcn_mfma_f32_16x16x32_fp8_fp8(ka0[kt], bqa[0], z, 0, 0, 0);
            sacc[kt] = __builtin_amdgcn_mfma_f32_16x16x32_fp8_fp8(ka1[kt], bqa[1], z, 0, 0, 0);
        }
        if (hc < 4) {
#pragma unroll
            for (int kt = 0; kt < 16; ++kt)
#pragma unroll
                for (int r = 0; r < 4; ++r) pl[(kt * 16 + lg * 4 + r) * 4 + hc] = sacc[kt][r];
        }
        __builtin_amdgcn_fence(__ATOMIC_RELEASE, "workgroup");
        __builtin_amdgcn_wave_barrier();
        __builtin_amdgcn_fence(__ATOMIC_ACQUIRE, "workgroup");
        {
            f32x4 lv[4];
            f32x4 mh = {-INFINITY, -INFINITY, -INFINITY, -INFINITY};
#pragma unroll
            for (int i = 0; i < 4; ++i) {
                const f32x4 raw = *(const f32x4*)&pl[(lane * 4 + i) * 4];
                const bool valid = (lane * 4 + i) < nvalid;
#pragma unroll
                for (int hq = 0; hq < 4; ++hq) { lv[i][hq] = valid ? raw[hq] * 0.125f : -INFINITY; mh[hq] = fmaxf(mh[hq], lv[i][hq]); }
            }
#pragma unroll
            for (int hq = 0; hq < 4; ++hq) mh[hq] = wave_max(mh[hq]);
            f32x4 sh = {0.f, 0.f, 0.f, 0.f};
#pragma unroll
            for (int i = 0; i < 4; ++i)
#pragma unroll
                for (int hq = 0; hq < 4; ++hq) { const float e = __expf(lv[i][hq] - mh[hq]); lv[i][hq] = e; sh[hq] += e; }
#pragma unroll
            for (int hq = 0; hq < 4; ++hq) sh[hq] = wave_sum(sh[hq]);
            const f32x4 inv = {1.f / sh[0], 1.f / sh[1], 1.f / sh[2], 1.f / sh[3]};
#pragma unroll
            for (int i = 0; i < 4; ++i) *(f32x4*)&pl[(lane * 4 + i) * 4] = lv[i] * inv;
        }
        __builtin_amdgcn_fence(__ATOMIC_RELEASE, "workgroup");
        __builtin_amdgcn_wave_barrier();
        __builtin_amdgcn_fence(__ATOMIC_ACQUIRE, "workgroup");
        {
            typedef float f32x2 __attribute__((ext_vector_type(2)));
            f32x2 o[4][8];
#pragma unroll
            for (int hq = 0; hq < 4; ++hq)
#pragma unroll
                for (int e = 0; e < 8; ++e) o[hq][e] = (f32x2){0.f, 0.f};
#pragma unroll
            for (int it = 0; it < 16; ++it) {
                const int n = it * 16 + ks;
                const uint4 vv = vvs[it];
                const float4 p4 = *(const float4*)&pl[n * 4];
                f32x2 v[8];
                v[0] = __builtin_amdgcn_cvt_pk_f32_fp8((int)vv.x, false); v[1] = __builtin_amdgcn_cvt_pk_f32_fp8((int)vv.x, true);
                v[2] = __builtin_amdgcn_cvt_pk_f32_fp8((int)vv.y, false); v[3] = __builtin_amdgcn_cvt_pk_f32_fp8((int)vv.y, true);
                v[4] = __builtin_amdgcn_cvt_pk_f32_fp8((int)vv.z, false); v[5] = __builtin_amdgcn_cvt_pk_f32_fp8((int)vv.z, true);
                v[6] = __builtin_amdgcn_cvt_pk_f32_fp8((int)vv.w, false); v[7] = __builtin_amdgcn_cvt_pk_f32_fp8((int)vv.w, true);
#pragma unroll
                for (int e = 0; e < 8; ++e) { o[0][e] += v[e] * p4.x; o[1][e] += v[e] * p4.y; o[2][e] += v[e] * p4.z; o[3][e] += v[e] * p4.w; }
            }
#pragma unroll
            for (int hq = 0; hq < 4; ++hq)
#pragma unroll
                for (int e = 0; e < 8; ++e) { o[hq][e].x += dppf<0x104, 0xF>(0.f, o[hq][e].x); o[hq][e].y += dppf<0x104, 0xF>(0.f, o[hq][e].y); }
            float* red = (float*)(smem + T_RED) + wave * 2048;
            if ((lane & 4) == 0) {
                const int s8 = lane >> 3;
#pragma unroll
                for (int hq = 0; hq < 4; ++hq)
#pragma unroll
                    for (int e = 0; e < 4; ++e)
                        *(f32x4*)&red[(s8 * 4 + hq) * 64 + dc * 16 + 4 * e] = (f32x4){o[hq][2 * e].x, o[hq][2 * e].y, o[hq][2 * e + 1].x, o[hq][2 * e + 1].y};
            }
            __builtin_amdgcn_fence(__ATOMIC_RELEASE, "workgroup");
            __builtin_amdgcn_wave_barrier();
            __builtin_amdgcn_fence(__ATOMIC_ACQUIRE, "workgroup");
            {
                const int hq = lane >> 4, d4 = (lane & 15) * 4;
                f32x4 acc4 = {0.f, 0.f, 0.f, 0.f};
#pragma unroll
                for (int k2 = 0; k2 < 8; ++k2) acc4 += *(const f32x4*)&red[(k2 * 4 + hq) * 64 + d4];
                const int col = (g * 4 + hq) * 64 + d4;
                const uint2 zz = zzq;
                uint2 yy;
                yy.x = pk2(acc4[0] * siluf(bflo(zz.x)), acc4[1] * siluf(bfhi(zz.x))); yy.y = pk2(acc4[2] * siluf(bflo(zz.y)), acc4[3] * siluf(bfhi(zz.y)));
                *(uint2*)(YBR + tq * 1536 + col) = yy;
            }
        }
        __builtin_amdgcn_fence(__ATOMIC_RELEASE, "workgroup");
        __builtin_amdgcn_wave_barrier();
        __builtin_amdgcn_fence(__ATOMIC_ACQUIRE, "workgroup");
    }
    }
    __syncthreads();
}

constexpr int B_BIAS = 0, B_V = 8448, B_K = B_V + 8 * 64 * 144;
static_assert(B_K + 8 * 64 * 144 <= LDS_BYTES - 64, "b lds");
__device__ __forceinline__ void b_unit(const Params& p, int l, int c, unsigned char* smem) {
    unsigned char* ws_ = opaque_ptr(p.ws);
    const int tid = opaque_tid(), lane = tid & 63, wave = tid >> 6;
    const int q = lane & 31, hh = lane >> 5;
    const u16* P = (const u16*)(ws_ + OFF_P); u16* YBR = (u16*)(ws_ + OFF_YBR);
    float* bt = (float*)(smem + B_BIAS);
    __syncthreads();
    for (int i = tid; i < 8 * 257; i += 512) bt[i] = p.rel_bias[l * 8 * 257 + i];
    __syncthreads();
    const int h = wave;
    const float* bth = bt + h * 257;
    unsigned char* vl = smem + B_V + wave * (64 * 144);
    unsigned char* kl = smem + B_K + wave * (64 * 144);
    const int tc = c * 64;
    bf8 bq[2][4];
#pragma unroll
    for (int nt = 0; nt < 2; ++nt)
#pragma unroll
        for (int ks = 0; ks < 4; ++ks) bq[nt][ks] = ld_bf8(P + (size_t)(tc + nt * 32 + q) * PLD + C_BQ + h * 64 + ks * 16 + hh * 8);
    f32x16 oacc[2][2];
#pragma unroll
    for (int i = 0; i < 2; ++i)
#pragma unroll
        for (int j = 0; j < 2; ++j)
#pragma unroll
            for (int e = 0; e < 16; ++e) oacc[i][j][e] = 0.f;
    float mrun[2] = {-INFINITY, -INFINITY}, lsum[2] = {0.f, 0.f};
    const int g16 = lane >> 4, i16 = lane & 15, qrow = i16 >> 2, pp = i16 & 3, hp = g16 >> 1;
#pragma unroll 1
    for (int kc = (c < 8 ? 8 - c : 0); kc <= 8; ++kc) {
        const int kch = c - 8 + kc;
#pragma unroll
        for (int i = 0; i < 8; ++i) {
            const int id = lane + 64 * i, row = id >> 3, ch = id & 7;
            *(uint4*)(vl + row * 144 + ch * 16) = *(const uint4*)(P + (size_t)(kch * 64 + row) * PLD + C_BV + h * 64 + ch * 8);
        }
#pragma unroll
        for (int i = 0; i < 8; ++i) {
            const int id = lane + 64 * i, row = id >> 3, ch = id & 7;
            *(uint4*)(kl + row * 144 + ch * 16) = *(const uint4*)(P + (size_t)(kch * 64 + row) * PLD + C_BK + h * 64 + ch * 8);
        }
        __builtin_amdgcn_fence(__ATOMIC_RELEASE, "workgroup");
        __builtin_amdgcn_wave_barrier();
        __builtin_amdgcn_fence(__ATOMIC_ACQUIRE, "workgroup");
        f32x16 s[2][2];
#pragma unroll
        for (int mt = 0; mt < 2; ++mt) {
            bf8 ak[4];
#pragma unroll
            for (int ks = 0; ks < 4; ++ks) ak[ks] = ld_bf8(kl + (mt * 32 + q) * 144 + (ks * 2 + hh) * 16);
#pragma unroll
            for (int nt = 0; nt < 2; ++nt) {
#pragma unroll
                for (int e = 0; e < 16; ++e) s[mt][nt][e] = 0.f;
#pragma unroll
                for (int ks = 0; ks < 4; ++ks) s[mt][nt] = mfma32(ak[ks], bq[nt][ks], s[mt][nt]);
            }
        }
#pragma unroll
        for (int nt = 0; nt < 2; ++nt) {
            const int qi = nt * 32 + q;
            float tmax = -INFINITY;
            if (kc <= 5) {
                const float bfar = bth[256];
#pragma unroll
                for (int mt = 0; mt < 2; ++mt)
#pragma unroll
                    for (int reg = 0; reg < 16; ++reg) { const float v = fmaf(s[mt][nt][reg], 0.125f, bfar); s[mt][nt][reg] = v; tmax = fmaxf(tmax, v); }
            } else {
#pragma unroll
                for (int mt = 0; mt < 2; ++mt)
#pragma unroll
                    for (int reg = 0; reg < 16; ++reg) {
                        const int kk = mt * 32 + (reg & 3) + 8 * (reg >> 2) + 4 * hh;
                        int rel = 512 + qi - (kc * 64 + kk);
                        rel = rel > 128 ? 128 : rel; rel = rel < -128 ? -128 : rel;
                        const float v = s[mt][nt][reg] * 0.125f + bth[rel + 128];
                        s[mt][nt][reg] = v; tmax = fmaxf(tmax, v);
                    }
            }
            tmax = fmaxf(tmax, __shfl_xor(tmax, 32));
            const bool resc = __any(tmax > mrun[nt] + 8.f) != 0;
            float mnew = mrun[nt];
            if (resc) {
                mnew = fmaxf(mrun[nt], tmax);
                const float alpha = __expf(mrun[nt] - mnew);
                mrun[nt] = mnew;
                lsum[nt] *= alpha;
#pragma unroll
                for (int dmt = 0; dmt < 2; ++dmt)
#pragma unroll
                    for (int e = 0; e < 16; ++e) oacc[dmt][nt][e] *= alpha;
            }
            float ps = 0.f;
#pragma unroll
            for (int mt = 0; mt < 2; ++mt)
#pragma unroll
                for (int reg = 0; reg < 16; ++reg) { const float e = __expf(s[mt][nt][reg] - mnew); s[mt][nt][reg] = e; ps += e; }
            lsum[nt] += ps;
        }
        __builtin_amdgcn_fence(__ATOMIC_RELEASE, "workgroup");
        __builtin_amdgcn_wave_barrier();
        __builtin_amdgcn_fence(__ATOMIC_ACQUIRE, "workgroup");
#pragma unroll
        for (int mt = 0; mt < 2; ++mt)
#pragma unroll
            for (int sp = 0; sp < 2; ++sp) {
                const int rb = mt * 32 + 16 * sp + 4 * hp + qrow;
                bf8 av[2];
#pragma unroll
                for (int dmt = 0; dmt < 2; ++dmt) {
                    const unsigned char* a0 = vl + rb * 144 + (dmt * 32 + 16 * (g16 & 1) + 4 * pp) * 2;
                    av[dmt] = tr_pair(a0, a0 + 8 * 144);
                }
#pragma unroll
                for (int nt = 0; nt < 2; ++nt) {
                    const bf8 bp = pack8(s[mt][nt][8 * sp + 0], s[mt][nt][8 * sp + 1], s[mt][nt][8 * sp + 2], s[mt][nt][8 * sp + 3],
                                         s[mt][nt][8 * sp + 4], s[mt][nt][8 * sp + 5], s[mt][nt][8 * sp + 6], s[mt][nt][8 * sp + 7]);
#pragma unroll
                    for (int dmt = 0; dmt < 2; ++dmt) oacc[dmt][nt] = mfma32(av[dmt], bp, oacc[dmt][nt]);
                }
            }
        __builtin_amdgcn_fence(__ATOMIC_RELEASE, "workgroup");
        __builtin_amdgcn_wave_barrier();
        __builtin_amdgcn_fence(__ATOMIC_ACQUIRE, "workgroup");
    }
#pragma unroll
    for (int nt = 0; nt < 2; ++nt) {
        const float lt = lsum[nt] + __shfl_xor(lsum[nt], 32);
        const float inv = 1.f / lt;
        const size_t t = (size_t)(tc + nt * 32 + q);
#pragma unroll
        for (int dmt = 0; dmt < 2; ++dmt)
#pragma unroll
            for (int rg = 0; rg < 4; ++rg) {
                const int d0 = dmt * 32 + 8 * rg + 4 * hh;
                const uint2 zz = *(const uint2*)(P + t * PLD + C_BZ + h * 64 + d0);
                const float y0 = oacc[dmt][nt][4 * rg + 0] * inv * siluf(bflo(zz.x));
                const float y1 = oacc[dmt][nt][4 * rg + 1] * inv * siluf(bfhi(zz.x));
                const float y2 = oacc[dmt][nt][4 * rg + 2] * inv * siluf(bflo(zz.y));
                const float y3 = oacc[dmt][nt][4 * rg + 3] * inv * siluf(bfhi(zz.y));
                *(uint2*)(YBR + t * 1536 + 512 + h * 64 + d0) = make_uint2(pk2(y0, y1), pk2(y2, y3));
            }
    }
    __syncthreads();
}

__device__ __forceinline__ void conv8w(const u16* __restrict__ P, int t, int col, const float* __restrict__ cwl, const float* __restrict__ cbl, int cch, float (&out)[8]) {
    {
        const float4 a = *(const float4*)(cbl + cch), b = *(const float4*)(cbl + cch + 4);
        out[0] = a.x; out[1] = a.y; out[2] = a.z; out[3] = a.w; out[4] = b.x; out[5] = b.y; out[6] = b.z; out[7] = b.w;
    }
    uint4 rws[4]; float4 was[4], wbs[4];
#pragma unroll
    for (int j = 0; j < 4; ++j) {
        const int tr = t - 3 + j;
        rws[j] = *(const uint4*)(P + (size_t)(tr >= 0 ? tr : 0) * PLD + col);
        was[j] = *(const float4*)(cwl + j * 1024 + cch); wbs[j] = *(const float4*)(cwl + j * 1024 + cch + 4);
    }
#pragma unroll
    for (int j = 0; j < 4; ++j) {
        const bool ok = (t - 3 + j) >= 0;
        uint4 rw = rws[j];
        rw.x = ok ? rw.x : 0u; rw.y = ok ? rw.y : 0u; rw.z = ok ? rw.z : 0u; rw.w = ok ? rw.w : 0u;
        const float4 a = was[j], b = wbs[j];
        out[0] = fmaf(a.x, bflo(rw.x), out[0]); out[1] = fmaf(a.y, bfhi(rw.x), out[1]);
        out[2] = fmaf(a.z, bflo(rw.y), out[2]); out[3] = fmaf(a.w, bfhi(rw.y), out[3]);
        out[4] = fmaf(b.x, bflo(rw.z), out[4]); out[5] = fmaf(b.y, bfhi(rw.z), out[5]);
        out[6] = fmaf(b.z, bflo(rw.w), out[6]); out[7] = fmaf(b.w, bfhi(rw.w), out[7]);
    }
#pragma unroll
    for (int e = 0; e < 8; ++e) out[e] = siluf(out[e]);
}
struct Conv8In { uint4 rws[4]; float4 was[4], wbs[4], ba, bb; };
__device__ __forceinline__ void conv8_load(const u16* __restrict__ P, int t, int col, const float* __restrict__ cwl, const float* __restrict__ cbl, int cch, Conv8In& in) {
    in.ba = *(const float4*)(cbl + cch); in.bb = *(const float4*)(cbl + cch + 4);
#pragma unroll
    for (int j = 0; j < 4; ++j) {
        const int tr = t - 3 + j;
        in.rws[j] = *(const uint4*)(P + (size_t)(tr >= 0 ? tr : 0) * PLD + col);
        in.was[j] = *(const float4*)(cwl + j * 1024 + cch); in.wbs[j] = *(const float4*)(cwl + j * 1024 + cch + 4);
    }
}
__device__ __forceinline__ void conv8_compute(const Conv8In& in, int t, float (&out)[8]) {
    out[0] = in.ba.x; out[1] = in.ba.y; out[2] = in.ba.z; out[3] = in.ba.w; out[4] = in.bb.x; out[5] = in.bb.y; out[6] = in.bb.z; out[7] = in.bb.w;
#pragma unroll
    for (int j = 0; j < 4; ++j) {
        const bool ok = (t - 3 + j) >= 0;
        uint4 rw = in.rws[j];
        rw.x = ok ? rw.x : 0u; rw.y = ok ? rw.y : 0u; rw.z = ok ? rw.z : 0u; rw.w = ok ? rw.w : 0u;
        const float4 a = in.was[j], b = in.wbs[j];
        out[0] = fmaf(a.x, bflo(rw.x), out[0]); out[1] = fmaf(a.y, bfhi(rw.x), out[1]);
        out[2] = fmaf(a.z, bflo(rw.y), out[2]); out[3] = fmaf(a.w, bfhi(rw.y), out[3]);
        out[4] = fmaf(b.x, bflo(rw.z), out[4]); out[5] = fmaf(b.y, bfhi(rw.z), out[5]);
        out[6] = fmaf(b.z, bflo(rw.w), out[6]); out[7] = fmaf(b.w, bfhi(rw.w), out[7]);
    }
#pragma unroll
    for (int e = 0; e < 8; ++e) out[e] = siluf(out[e]);
}
__device__ __forceinline__ float scan_sum64(float v, int lane) {
    v += dppf<0x111, 0xF>(0.f, v); v += dppf<0x112, 0xF>(0.f, v); v += dppf<0x114, 0xF>(0.f, v); v += dppf<0x118, 0xF>(0.f, v);
    v += dppf<0x142, 0xA>(0.f, v); v += dppf<0x143, 0xC>(0.f, v);
    return v;
}
__device__ __forceinline__ float scan_max64(float v, int lane) {
    v = fmaxf(v, dppf<0x111, 0xF>(v, v)); v = fmaxf(v, dppf<0x112, 0xF>(v, v)); v = fmaxf(v, dppf<0x114, 0xF>(v, v)); v = fmaxf(v, dppf<0x118, 0xF>(v, v));
    v = fmaxf(v, dppf<0x142, 0xA>(v, v)); v = fmaxf(v, dppf<0x143, 0xC>(v, v));
    return v;
}
constexpr int ROWB = 288;
constexpr int C1_TW = 0, C1_K = 1024, C1_V = 1024 + 2 * 64 * ROWB;
__device__ __forceinline__ void c1_unit(const Params& p, int l, int c, unsigned char* smem) {
    unsigned char* ws_ = opaque_ptr(p.ws);
    const int tid = opaque_tid(), lane = tid & 63, wave = tid >> 6;
    const u16* P = (const u16*)(ws_ + OFF_P); const float* SM = (const float*)(ws_ + OFF_SM);
    float* KVS = (float*)(ws_ + OFF_KVS); float* NS = (float*)(ws_ + OFF_NS); float* GC = (float*)(ws_ + OFF_GC); float* ML = (float*)(ws_ + OFF_ML);
    const float* cwl = p.conv_w + (size_t)l * 4 * 1024; const float* cbl = p.conv_b + (size_t)l * 1024;
    float* tw = (float*)(smem + C1_TW);
    const int tc = c * 64;
    const int g16 = lane >> 4, i16 = lane & 15, qrow = i16 >> 2, pp = i16 & 3, hp = g16 >> 1;
#pragma unroll 1
    for (int hpair = 0; hpair < 2; ++hpair) {
        __syncthreads();
        if ((wave & 3) == 0) {
            const int hl = wave >> 2, h = 2 * hpair + hl;
            const float fpre = SM[(size_t)(tc + lane) * 16 + 8 + h], ipre = SM[(size_t)(tc + lane) * 16 + 4 + h];
            const float bcum = scan_sum64(logsigmoidf(fpre), lane);
            const float u = ipre - bcum;
            const float umax = wave_max(u);
            tw[hl * 64 + lane] = __expf(u - umax);
            if (lane == 63) { GC[h * NCH + c] = bcum; ML[h * NCH + c] = bcum + umax; }
        }
        __syncthreads();
#pragma unroll 1
        for (int i = 0; i < 4; ++i) {
            const int item = tid + 512 * i, hl = item >> 10, row = (item >> 4) & 63, ch = item & 15, h = 2 * hpair + hl;
            Conv8In ink, inq;
            conv8_load(P, tc + row, C_CK + h * 128 + ch * 8, cwl, cbl, 512 + h * 128 + ch * 8, ink);
            conv8_load(P, tc + row, C_CQ + h * 128 + ch * 8, cwl, cbl, h * 128 + ch * 8, inq);
            const uint4 vrow = *(const uint4*)(P + (size_t)(tc + row) * PLD + C_CV + h * 128 + ch * 8);
            float o[8];
            conv8_compute(ink, tc + row, o);
            {
                u16* KC = (u16*)(ws_ + OFF_MG) + (size_t)SEQ * 512; u16* QC = (u16*)(ws_ + OFF_MG);
                uint4 kc; kc.x = pk2(o[0], o[1]); kc.y = pk2(o[2], o[3]); kc.z = pk2(o[4], o[5]); kc.w = pk2(o[6], o[7]);
                *(uint4*)(KC + (size_t)(tc + row) * 512 + h * 128 + ch * 8) = kc;
                float oq[8];
                conv8_compute(inq, tc + row, oq);
                const float qs = 0.08838834764831845f;
                uint4 qc; qc.x = pk2(oq[0] * qs, oq[1] * qs); qc.y = pk2(oq[2] * qs, oq[3] * qs); qc.z = pk2(oq[4] * qs, oq[5] * qs); qc.w = pk2(oq[6] * qs, oq[7] * qs);
                *(uint4*)(QC + (size_t)(tc + row) * 512 + h * 128 + ch * 8) = qc;
            }
            const float wg = tw[hl * 64 + row];
            uint4 kk; kk.x = pk2(o[0] * wg, o[1] * wg); kk.y = pk2(o[2] * wg, o[3] * wg); kk.z = pk2(o[4] * wg, o[5] * wg); kk.w = pk2(o[6] * wg, o[7] * wg);
            *(uint4*)(smem + C1_K + hl * 64 * ROWB + row * ROWB + ch * 16) = kk;
            *(uint4*)(smem + C1_V + hl * 64 * ROWB + row * ROWB + ch * 16) = vrow;
        }
        __syncthreads();
        {
            const int hl = wave >> 2, ws = wave & 3, h = 2 * hpair + hl;
            const unsigned char* kb = smem + C1_K + hl * 64 * ROWB; const unsigned char* vb = smem + C1_V + hl * 64 * ROWB;
            f32x16 acc[5];
#pragma unroll
            for (int i = 0; i < 5; ++i)
#pragma unroll
                for (int e = 0; e < 16; ++e) acc[i][e] = 0.f;
            const bf8 ones = pack8(1.f, 1.f, 1.f, 1.f, 1.f, 1.f, 1.f, 1.f), zeros = pack8(0.f, 0.f, 0.f, 0.f, 0.f, 0.f, 0.f, 0.f);
            const bf8 aext = ((lane & 31) == 0) ? ones : zeros;
#pragma unroll
            for (int ks = 0; ks < 4; ++ks) {
                const int rb = 16 * ks + 8 * hp + qrow;
                const unsigned char* b0 = kb + rb * ROWB + (32 * ws + 16 * (g16 & 1) + 4 * pp) * 2;
                const bf8 bfr = tr_pair(b0, b0 + 4 * ROWB);
#pragma unroll
                for (int emt = 0; emt < 4; ++emt) {
                    const unsigned char* a0 = vb + rb * ROWB + (32 * emt + 16 * (g16 & 1) + 4 * pp) * 2;
                    const bf8 afr = tr_pair(a0, a0 + 4 * ROWB);
                    acc[emt] = mfma32(afr, bfr, acc[emt]);
                }
                acc[4] = mfma32(aext, bfr, acc[4]);
            }
            float* ct = KVS + ((size_t)(h * NCH + c) * 128) * 128;
            const int d = 32 * ws + (lane & 31);
#pragma unroll
            for (int emt = 0; emt < 4; ++emt)
#pragma unroll
                for (int reg = 0; reg < 16; ++reg) {
                    const int e = emt * 32 + (reg & 3) + 8 * (reg >> 2) + 4 * (lane >> 5);
                    ct[(size_t)e * 128 + d] = acc[emt][reg];
                }
            if ((lane >> 5) == 0) NS[(size_t)(h * NCH + c) * 128 + d] = acc[4][0];
        }
    }
    __syncthreads();
}
__device__ __forceinline__ void m2_unit(const Params& p, int item, unsigned char* smem) {
    unsigned char* ws_ = opaque_ptr(p.ws);
    const int tid = opaque_tid();
    float* KVS = (float*)(ws_ + OFF_KVS); float* NS = (float*)(ws_ + OFF_NS);
    const float* GC = (const float*)(ws_ + OFF_GC); const float* ML = (const float*)(ws_ + OFF_ML); float* MP = (float*)(ws_ + OFF_MP);
    float* sa = (float*)smem; float* sb = sa + 1024;
    {
        __syncthreads();
        for (int i = tid; i < 1024; i += 512) { sa[i] = GC[i]; sb[i] = ML[i]; }
        __syncthreads();
        if (tid < 256) {
            const int h = tid >> 6, ln = tid & 63;
            float g[4], ml[4];
#pragma unroll
            for (int k = 0; k < 4; ++k) { g[k] = sa[h * NCH + 4 * ln + k]; ml[k] = sb[h * NCH + 4 * ln + k]; }
            float G = 0.f, M = -INFINITY;
#pragma unroll
            for (int k = 0; k < 4; ++k) { G += g[k]; M = fmaxf(M + g[k], ml[k]); }
#define M2_STEP(CTRL, RM) { const float Gp = dppf<CTRL, RM>(0.f, G), Mp = dppf<CTRL, RM>(-INFINITY, M); M = fmaxf(Mp + G, M); G = Gp + G; }
            M2_STEP(0x111, 0xF) M2_STEP(0x112, 0xF) M2_STEP(0x114, 0xF) M2_STEP(0x118, 0xF) M2_STEP(0x142, 0xA) M2_STEP(0x143, 0xC)
#undef M2_STEP
            const float Ge = dppf<0x138, 0xF>(0.f, G), Me = dppf<0x138, 0xF>(-INFINITY, M);
            float m = (ln == 0) ? 0.f : fmaxf(Ge, Me);
#pragma unroll
            for (int k = 0; k < 4; ++k) {
                const int c = 4 * ln + k;
                const float mn = fmaxf(g[k] + m, ml[k]);
                sa[h * NCH + c] = __expf(g[k] + m - mn); sb[h * NCH + c] = __expf(ml[k] - mn);
                if (item == 128) MP[h * NCH + c] = m;
                m = mn;
            }
        }
        __syncthreads();
        if (item < 128) {
            {
                const int h = item >> 5, idx = (item & 31) * 512 + tid;
                float* base = KVS + (size_t)h * NCH * 16384 + idx;
                u16* baseb = (u16*)(ws_ + OFF_CTB) + (size_t)h * NCH * 16384 + idx;
                const float* a = sa + h * NCH; const float* bb = sb + h * NCH;
                float C = 0.f;
#pragma unroll 1
                for (int c0 = 0; c0 < NCH; c0 += 32) {
                    float kv[32];
#pragma unroll
                    for (int j = 0; j < 32; ++j) kv[j] = base[(size_t)(c0 + j) * 16384];
#pragma unroll
                    for (int j = 0; j < 32; ++j) { baseb[(size_t)(c0 + j) * 16384] = f2bf(C); C = a[c0 + j] * C + bb[c0 + j] * kv[j]; }
                }
            }
        } else {
            const int h = tid >> 7, d = tid & 127;
            float* base = NS + (size_t)h * NCH * 128 + d;
            float n = 0.f;
#pragma unroll 1
            for (int c0 = 0; c0 < NCH; c0 += 16) {
                float ks[16];
#pragma unroll
                for (int j = 0; j < 16; ++j) ks[j] = base[(size_t)(c0 + j) * 128];
#pragma unroll
                for (int j = 0; j < 16; ++j) { base[(size_t)(c0 + j) * 128] = n; n = sa[h * NCH + c0 + j] * n + sb[h * NCH + c0 + j] * ks[j]; }
            }
        }
    }
    __syncthreads();
}
constexpr int C3_V = 0, C3_TB = 4 * 64 * ROWB, C3_BQ = C3_TB + 8 * 768;
static_assert(C3_BQ + 2048 + 8 * 32 * 272 <= LDS_BYTES - 64, "c3 lds");
__device__ __forceinline__ void c3_unit(const Params& p, int l, int c, unsigned char* smem) {
    unsigned char* ws_ = opaque_ptr(p.ws);
    const int tid = opaque_tid(), lane = tid & 63, wave = tid >> 6;
    const int q = lane & 31, hh = lane >> 5;
    const u16* P = (const u16*)(ws_ + OFF_P); const float* SM = (const float*)(ws_ + OFF_SM); u16* YBR = (u16*)(ws_ + OFF_YBR);
    const float* KVS = (const float*)(ws_ + OFF_KVS); const float* NS = (const float*)(ws_ + OFF_NS); const float* MP = (const float*)(ws_ + OFF_MP);
    const float* cwl = p.conv_w + (size_t)l * 4 * 1024; const float* cbl = p.conv_b + (size_t)l * 1024;
    const int tc = c * 64;
    const int h = wave >> 1, qh = wave & 1;
    __syncthreads();
    {
        uint4 vst8[8];
#pragma unroll
        for (int i = 0; i < 8; ++i) {
            const int item = tid + 512 * i, hv = item >> 10, row = (item >> 4) & 63, ch = item & 15;
            vst8[i] = *(const uint4*)(P + (size_t)(tc + row) * PLD + C_CV + hv * 128 + ch * 8);
        }
#pragma unroll
        for (int i = 0; i < 8; ++i) {
            const int item = tid + 512 * i, hv = item >> 10, row = (item >> 4) & 63, ch = item & 15;
            *(uint4*)(smem + C3_V + hv * 64 * ROWB + row * ROWB + ch * 16) = vst8[i];
        }
    }
    if (tid < 128) *(float4*)(smem + C3_BQ + tid * 16) = *(const float4*)(p.c_norm_w + l * 512 + tid * 4);
    float* tb = (float*)(smem + C3_TB) + wave * 192; float* tu = tb + 64; float* tcm = tb + 128;
    const float mprev = MP[h * NCH + c];
    {
        const float fpre = SM[(size_t)(tc + lane) * 16 + 8 + h], ipre = SM[(size_t)(tc + lane) * 16 + 4 + h];
        const float bcum = scan_sum64(logsigmoidf(fpre), lane);
        const float u = ipre - bcum;
        const float cm = fmaxf(scan_max64(u, lane), mprev);
        tb[lane] = bcum; tu[lane] = u; tcm[lane] = cm;
    }
    __syncthreads();
    const int lq = qh * 32 + q;
    const float cmq = tcm[lq], bq_ = tb[lq];
    const u16* QC = (const u16*)(ws_ + OFF_MG) + (size_t)(tc + lq) * 512 + h * 128 + hh * 8;
    const u16* KC = (const u16*)(ws_ + OFF_MG) + (size_t)SEQ * 512 + (size_t)(tc + q) * 512 + h * 128 + hh * 8;
    f32x16 xacc[2];
#pragma unroll
    for (int i = 0; i < 2; ++i)
#pragma unroll
        for (int e = 0; e < 16; ++e) xacc[i][e] = 0.f;
#pragma unroll
    for (int ks = 0; ks < 8; ++ks) {
        const bf8 bqv = ld_bf8(QC + ks * 16);
#pragma unroll
        for (int mt = 0; mt < 2; ++mt) xacc[mt] = mfma32(ld_bf8(KC + (size_t)mt * 32 * 512 + ks * 16), bqv, xacc[mt]);
    }
#pragma unroll
    for (int mt = 0; mt < 2; ++mt)
#pragma unroll
        for (int reg = 0; reg < 16; ++reg) {
            const int s = mt * 32 + (reg & 3) + 8 * (reg >> 2) + 4 * hh;
            const float wgt = (s <= lq) ? __expf(tu[s] - cmq) : 0.f;
            xacc[mt][reg] *= wgt;
        }
    f32x16 num[5];
#pragma unroll
    for (int i = 0; i < 5; ++i)
#pragma unroll
        for (int e = 0; e < 16; ++e) num[i][e] = 0.f;
    const u16* ct = (const u16*)(ws_ + OFF_CTB) + ((size_t)(h * NCH + c) * 128) * 128;
    const float* nsv = NS + (size_t)(h * NCH + c) * 128;
#pragma unroll
    for (int ks = 0; ks < 8; ++ks) {
        const int d0 = ks * 16 + hh * 8;
        const bf8 bqv = ld_bf8(QC + ks * 16);
#pragma unroll
        for (int emt = 0; emt < 4; ++emt) {
            const bf8 af = ld_bf8(ct + (size_t)(emt * 32 + q) * 128 + d0);
            num[emt] = mfma32(af, bqv, num[emt]);
        }
        float4 n0 = make_float4(0.f, 0.f, 0.f, 0.f), n1 = n0;
        if (q == 0) { n0 = *(const float4*)(nsv + d0); n1 = *(const float4*)(nsv + d0 + 4); }
        const bf8 an = pack8(n0.x, n0.y, n0.z, n0.w, n1.x, n1.y, n1.z, n1.w);
        num[4] = mfma32(an, bqv, num[4]);
    }
    const float isc = __expf(mprev - cmq);
#pragma unroll
    for (int i = 0; i < 5; ++i)
#pragma unroll
        for (int e = 0; e < 16; ++e) num[i][e] *= isc;
    const size_t t = (size_t)(tc + lq);
    uint2 ozr[16];
#pragma unroll
    for (int emt = 0; emt < 4; ++emt)
#pragma unroll
        for (int rg = 0; rg < 4; ++rg) ozr[emt * 4 + rg] = *(const uint2*)(P + t * PLD + C_CO + h * 128 + emt * 32 + 8 * rg + 4 * hh);
    const int g16 = lane >> 4, i16 = lane & 15, qrow = i16 >> 2, pp = i16 & 3, hp = g16 >> 1;
    const unsigned char* vb = smem + C3_V + h * 64 * ROWB;
    const bf8 ones = pack8(1.f, 1.f, 1.f, 1.f, 1.f, 1.f, 1.f, 1.f), zeros = pack8(0.f, 0.f, 0.f, 0.f, 0.f, 0.f, 0.f, 0.f);
    const bf8 aext = (q == 0) ? ones : zeros;
#pragma unroll
    for (int mt = 0; mt < 2; ++mt)
#pragma unroll
        for (int sp = 0; sp < 2; ++sp) {
            const bf8 bp = pack8(xacc[mt][8 * sp + 0], xacc[mt][8 * sp + 1], xacc[mt][8 * sp + 2], xacc[mt][8 * sp + 3],
                                 xacc[mt][8 * sp + 4], xacc[mt][8 * sp + 5], xacc[mt][8 * sp + 6], xacc[mt][8 * sp + 7]);
            const int rb = mt * 32 + 16 * sp + 4 * hp + qrow;
#pragma unroll
            for (int emt = 0; emt < 4; ++emt) {
                const unsigned char* a0 = vb + rb * ROWB + (32 * emt + 16 * (g16 & 1) + 4 * pp) * 2;
                const bf8 af = tr_pair(a0, a0 + 8 * ROWB);
                num[emt] = mfma32(af, bp, num[emt]);
            }
            num[4] = mfma32(aext, bp, num[4]);
            __builtin_amdgcn_sched_barrier(0);
        }
    uint2 zzr[16];
#pragma unroll
    for (int emt = 0; emt < 4; ++emt)
#pragma unroll
        for (int rg = 0; rg < 4; ++rg) zzr[emt * 4 + rg] = *(const uint2*)(P + t * PLD + C_CZ + h * 128 + emt * 32 + 8 * rg + 4 * hh);
    const float den = __shfl(num[4][0], q);
    const float mrow = bq_ + cmq;
    const float dn = fmaxf(fabsf(den), __expf(-mrow));
    const float rdn = 1.f / dn;
    float s1 = 0.f, s2 = 0.f;
#pragma unroll
    for (int emt = 0; emt < 4; ++emt)
#pragma unroll
        for (int rg = 0; rg < 4; ++rg) {
            const int e0 = emt * 32 + 8 * rg + 4 * hh;
            const uint2 oz = ozr[emt * 4 + rg];
            const float v0 = num[emt][4 * rg + 0] * rdn * sigmoidf(bflo(oz.x));
            const float v1 = num[emt][4 * rg + 1] * rdn * sigmoidf(bfhi(oz.x));
            const float v2 = num[emt][4 * rg + 2] * rdn * sigmoidf(bflo(oz.y));
            const float v3 = num[emt][4 * rg + 3] * rdn * sigmoidf(bfhi(oz.y));
            num[emt][4 * rg + 0] = v0; num[emt][4 * rg + 1] = v1; num[emt][4 * rg + 2] = v2; num[emt][4 * rg + 3] = v3;
            s1 += v0 + v1 + v2 + v3; s2 += v0 * v0 + v1 * v1 + v2 * v2 + v3 * v3;
            __builtin_amdgcn_sched_barrier(0);
        }
    s1 += __shfl_xor(s1, 32); s2 += __shfl_xor(s2, 32);
    const float mu = s1 * (1.f / 128.f);
    const float var = fmaxf(s2 * (1.f / 128.f) - mu * mu, 0.f);
    const float rs = rsqrtf(var + 1e-6f);
    const float* cnw = (const float*)(smem + C3_BQ) + h * 128;
    unsigned char* ystg = smem + C3_BQ + 2048 + wave * (32 * 272);
#pragma unroll
    for (int emt = 0; emt < 4; ++emt)
#pragma unroll
        for (int rg = 0; rg < 4; ++rg) {
            const int e0 = emt * 32 + 8 * rg + 4 * hh;
            const uint2 zz = zzr[emt * 4 + rg];
            const float4 nw = *(const float4*)(cnw + e0);
            const float y0 = (num[emt][4 * rg + 0] - mu) * rs * nw.x * siluf(bflo(zz.x));
            const float y1 = (num[emt][4 * rg + 1] - mu) * rs * nw.y * siluf(bfhi(zz.x));
            const float y2 = (num[emt][4 * rg + 2] - mu) * rs * nw.z * siluf(bflo(zz.y));
            const float y3 = (num[emt][4 * rg + 3] - mu) * rs * nw.w * siluf(bfhi(zz.y));
            *(uint2*)(ystg + q * 272 + e0 * 2) = make_uint2(pk2(y0, y1), pk2(y2, y3));
            __builtin_amdgcn_sched_barrier(0);
        }
    __builtin_amdgcn_fence(__ATOMIC_RELEASE, "workgroup");
    __builtin_amdgcn_wave_barrier();
    __builtin_amdgcn_fence(__ATOMIC_ACQUIRE, "workgroup");
#pragma unroll
    for (int i = 0; i < 8; ++i) {
        const int rw = i * 4 + (lane >> 4), chn = lane & 15;
        const uint4 d = *(const uint4*)(ystg + rw * 272 + chn * 16);
        *(uint4*)(YBR + (size_t)(tc + qh * 32 + rw) * 1536 + 1024 + h * 128 + chn * 8) = d;
    }
    __syncthreads();
}

__global__ void __launch_bounds__(512) mega(Params p) {
    extern __shared__ __attribute__((aligned(16))) unsigned char smem[];
    cg::grid_group grid = cg::this_grid();
    if (blockIdx.x == 0) { for (int i = threadIdx.x; i < (int)(CTL_BYTES / 4); i += 512) ((u32*)(p.ws + OFF_CTL))[i] = 0; }
    volatile LAS unsigned* xst = (volatile LAS unsigned*)(smem + LDS_BYTES - 32);
    if (threadIdx.x == 0) { xst[0] = 0; xst[1] = 0; }
    phase_p0(p, smem);
    phase_px(p, p.x);
    grid.sync();
    const XcdBarrier xb = xcd_barrier_post((unsigned*)(p.ws + OFF_BAR), xst);
#pragma unroll 1
    for (int l = 0; l < 2; ++l) {
        if (l == 1) { phase_px(p, p.out); xcd_barrier(xb); }
#pragma unroll 1
        for (int b = 0; b < NBATCH; ++b) {
            for (int rep = 0; rep < DUP_G1; ++rep) phase_g1(p, l, b, smem);
            xcd_barrier(xb);
            {
                u32* qhead = (u32*)(p.ws + OFF_CTL) + (l * 2 + b) * 8;
                u32* qslot = (u32*)(smem + LDS_BYTES - 16);
#pragma unroll 1
                for (;;) {
                    __syncthreads();
                    if (threadIdx.x == 0) *qslot = atomicAdd(qhead, 1u);
                    __syncthreads();
                    const int item = (int)*qslot;
                    if (item >= 1024) break;
                    if (item < 512) a_unit(p, 255 - (item >> 1), item & 1, smem);
                    else if (item < 768) { for (int rep = 0; rep < DUP_B; ++rep) b_unit(p, l, item - 512, smem); }
                    else { for (int rep = 0; rep < DUP_C1; ++rep) c1_unit(p, l, item - 768, smem); }
                }
            }
            xcd_barrier(xb);
            {
                u32* qheads = (u32*)(p.ws + OFF_CTL) + (l * 2 + b) * 8 + 1;
                u32* qslot = (u32*)(smem + LDS_BYTES - 16);
#pragma unroll 1
                for (;;) {
                    __syncthreads();
                    if (threadIdx.x == 0) *qslot = atomicAdd(qheads + 2, 1u);
                    __syncthreads();
                    const int item = (int)*qslot;
                    if (item >= 129) break;
                    m2_unit(p, item, smem);
                    asm volatile("s_waitcnt vmcnt(0)" ::: "memory");
                    __syncthreads();
                    if (threadIdx.x == 0) {
                        __builtin_amdgcn_fence(__ATOMIC_RELEASE, "agent");
                        asm volatile("s_waitcnt vmcnt(0)" ::: "memory");
                        __hip_atomic_fetch_add(qheads + 3, 1u, __ATOMIC_RELAXED, __HIP_MEMORY_SCOPE_AGENT);
                    }
                }
                const int g0 = (int)(xb.x & 1u);
                int natt = 0; bool c3_done = false;
#pragma unroll 1
                for (int pass = 0; pass < 2; ++pass) {
                    const int g = g0 ^ pass;
#pragma unroll 1
                    for (;;) {
                        if (!c3_done && (natt >= 2 || pass == 1)) {
                            bool acquired = false;
#pragma unroll 1
                            for (;;) {
                                __syncthreads();
                                if (threadIdx.x == 0) *qslot = atomicAdd(qheads + 4, 1u);
                                __syncthreads();
                                const int citem = (int)*qslot;
                                if (citem >= 256) break;
                                if (!acquired) {
                                    if (threadIdx.x == 0) {
                                        unsigned spins = 0;
                                        while (__hip_atomic_load(qheads + 3, __ATOMIC_RELAXED, __HIP_MEMORY_SCOPE_AGENT) < 129u) { __builtin_amdgcn_s_sleep(2); if (++spins > (1u << 24)) break; }
                                        __builtin_amdgcn_fence(__ATOMIC_ACQUIRE, "agent");
                                        asm volatile("s_waitcnt vmcnt(0)" ::: "memory");
                                    }
                                    __syncthreads();
                                    acquired = true;
                                }
                                for (int rep = 0; rep < DUP_C3; ++rep) c3_unit(p, l, citem, smem);
                            }
                            c3_done = true;
                        }
                        __syncthreads();
                        if (threadIdx.x == 0) *qslot = atomicAdd(qheads + g, 1u);
                        __syncthreads();
                        const int item = (int)*qslot;
                        if (item >= 640) break;
                        if (item < 384) att_unit(p, 255 - (item >> 1), item & 1, g, 0, 4, smem);
                        else { const int u2 = 384 + ((item - 384) >> 1), hq2 = (item - 384) & 1; att_unit(p, 255 - (u2 >> 1), u2 & 1, g, 2 * hq2, 2 * hq2 + 2, smem); }
                        ++natt;
                    }
                }
            }
            xcd_barrier(xb);
            for (int rep = 0; rep < DUP_G2; ++rep) phase_g2(p, l, b, smem);
            xcd_barrier(xb);
            phase_g3(p, l, b, smem);
            xcd_barrier(xb);
        }
    }
    phase_pf(p);
}

extern "C" void kernel_launch(void* const* d_in, const int* in_sizes, int n_in, void* d_out, int out_size, void* d_ws, size_t ws_size, hipStream_t stream) {
    static int grid_blocks = 0;
    if (!grid_blocks) {
        int dev = 0, cus = 0, per_cu = 0;
        hipGetDevice(&dev);
        hipDeviceGetAttribute(&cus, hipDeviceAttributeMultiprocessorCount, dev);
        hipFuncSetAttribute((const void*)mega, hipFuncAttributeMaxDynamicSharedMemorySize, LDS_BYTES);
        hipOccupancyMaxActiveBlocksPerMultiprocessor(&per_cu, mega, 512, LDS_BYTES);
        if (per_cu < 1) { fprintf(stderr, "occupancy query says 0 blocks/CU\n"); per_cu = 1; }
        grid_blocks = cus;
        if (ws_size < WS_NEED) fprintf(stderr, "workspace too small: %zu < %zu\n", ws_size, (size_t)WS_END);
    }
    Params p{};
    p.x = (const float*)d_in[0]; p.norm_g = (const float*)d_in[1]; p.w_in = (const float*)d_in[2]; p.b_in = (const float*)d_in[3];
    p.f_bias = (const float*)d_in[4]; p.conv_w = (const float*)d_in[5]; p.conv_b = (const float*)d_in[6]; p.rel_bias = (const float*)d_in[7];
    p.c_norm_w = (const float*)d_in[8]; p.w_branch = (const float*)d_in[9]; p.w_out = (const float*)d_in[10]; p.final_g = (const float*)d_in[11];
    p.out = (float*)d_out; p.ws = (unsigned char*)d_ws;
    void* args[] = {&p};
    hipError_t e = hipLaunchCooperativeKernel((void*)mega, dim3(grid_blocks), dim3(512), args, LDS_BYTES, stream);
    if (e != hipSuccess) fprintf(stderr, "cooperative launch failed: %s (grid %d)\n", hipGetErrorString(e), grid_blocks);
}
```
